# Optimizing an MI355X kernel written in HIP

```python
import math
import jax, jax.numpy as jnp
from jax import lax
import numpy as np

D_MODEL = 1024
BATCH = 32
SEQ = 2048
DEPTH = 1
DEC_BATCH = 8
DEC_SEQ = 16
PAST_LEN = 2048

CHUNK = 64
Q_BLOCK = 128
N_MEM = 256
H_A = 4
DK_A = 64
DV_A = 2 * DK_A
W_A = H_A * DV_A
H_B = 4
DH_B = 64
W_B = H_B * DH_B
H_M = 4
DH_M = 64
W_M = H_M * DH_M
D_MIX = W_A + W_B + W_M
EPS = 1e-6
ALIBI_SLOPES = tuple(2.0 ** (-8.0 * (h + 1) / H_A) for h in range(H_A))
IN_SIZES = (W_A, W_A, W_A, W_A, W_B, W_B, W_B, W_B, H_B, H_B, W_B, W_M, W_M)
N_IN = 4 * W_A + 5 * W_B + 2 * H_B + 2 * W_M

kernel_name = "hymba_diffattn_mlstm_stream_step"

F32 = jnp.float32


def rms_norm(x, g):
    xf = x.astype(F32)
    y = xf * lax.rsqrt(jnp.mean(xf * xf, axis=-1, keepdims=True) + EPS)
    return (y * g.astype(F32)).astype(x.dtype)


def split_cols(z):
    out, start = [], 0
    for size in IN_SIZES:
        out.append(z[..., start:start + size])
        start += size
    return out


def diff_attention(q, k, v, q_pos, k_pos, lam):
    slopes = jnp.asarray(ALIBI_SLOPES, F32)
    scale = DK_A ** -0.5
    k_chunk = k_pos // CHUNK

    def block(args):
        qb, qp = args
        s = jnp.einsum('bqhmd,bkhmd->bhmqk', qb, k, preferred_element_type=F32) * scale
        dist = jnp.abs(qp[:, None] - k_pos[None, :]).astype(F32)
        bias = -slopes[:, None, None, None] * dist
        allowed = k_chunk[None, :] <= (qp // CHUNK)[:, None]
        s = jnp.where(allowed, s + bias, -jnp.inf)
        p = jax.nn.softmax(s, axis=-1)
        w = p[:, :, 0] - lam * p[:, :, 1]
        return jnp.einsum('bhqk,bkhd->bqhd', w.astype(v.dtype), v)

    B, Sq = q.shape[0], q.shape[1]
    if Sq <= Q_BLOCK:
        return block((q, q_pos))
    nb = Sq // Q_BLOCK
    qs = q.reshape((B, nb, Q_BLOCK) + q.shape[2:]).swapaxes(0, 1)
    ps = q_pos.reshape(nb, Q_BLOCK)
    out = lax.map(block, (qs, ps))
    return out.swapaxes(0, 1).reshape(B, Sq, H_A, DV_A)


def mlstm_chunk(carry, inp):
    C0, n0, m0 = carry
    q, k, v, ig, lf = inp
    L = q.shape[2]
    b = jnp.cumsum(lf, axis=-1)
    causal = jnp.tril(jnp.ones((L, L), dtype=bool))
    D = jnp.where(causal, b[..., :, None] - b[..., None, :] + ig[..., None, :], -jnp.inf)
    g = b + m0[..., None]
    m = jnp.maximum(g, jnp.max(D, axis=-1))
    Dw = jnp.exp(D - m[..., None])
    gw = jnp.exp(g - m)
    A = jnp.einsum('bhtd,bhsd->bhts', q, k) * Dw
    num = gw[..., None] * jnp.einsum('bhtd,bhde->bhte', q, C0) + jnp.einsum('bhts,bhse->bhte', A, v)
    den = gw * jnp.einsum('bhtd,bhd->bht', q, n0) + jnp.sum(A, axis=-1)
    h = num / jnp.maximum(jnp.abs(den), jnp.exp(-m))[..., None]
    mL = m[..., -1]
    wS = jnp.exp(b[..., -1:] - b + ig - mL[..., None])
    decay = jnp.exp(b[..., -1] + m0 - mL)
    C = decay[..., None, None] * C0 + jnp.einsum('bhs,bhsd,bhse->bhde', wS, k, v)
    n = decay[..., None] * n0 + jnp.einsum('bhs,bhsd->bhd', wS, k)
    return (C, n, mL), h


def mlstm_run(q, k, v, ig, lf, state):
    B, S = q.shape[0], q.shape[1]
    q, k, v, ig, lf = [jnp.moveaxis(a.astype(F32), 1, 2) for a in (q, k, v, ig, lf)]
    state = tuple(s.astype(F32) for s in state)
    if S <= CHUNK:
        state, h = mlstm_chunk(state, (q, k, v, ig, lf))
    else:
        nc = S // CHUNK

        def chunks(a):
            a = a.reshape(a.shape[:2] + (nc, CHUNK) + a.shape[3:])
            return jnp.moveaxis(a, 2, 0)

        state, h = lax.scan(mlstm_chunk, state, tuple(chunks(a) for a in (q, k, v, ig, lf)))
        h = jnp.moveaxis(h, 0, 2).reshape(B, H_B, S, DH_B)
    return jnp.moveaxis(h, 2, 1), state


def memory_kv(mem, g_mem, w_mk, w_mv, g_km):
    B, N, _ = mem.shape
    hm = rms_norm(mem, g_mem)
    mk = rms_norm(jnp.einsum('bnd,de->bne', hm, w_mk).reshape(B, N, H_M, DH_M), g_km)
    mv = jnp.einsum('bnd,de->bne', hm, w_mv).reshape(B, N, H_M, DH_M)
    return mk, mv


def mixer_layer(x, q_pos, past_k, past_v, mlstm_state, mem_k, mem_v, lam_init,
                g_norm, w_in, w_out, g_qa, g_ka, lam_q1, lam_k1, lam_q2, lam_k2, g_subln,
                b_i, b_f, g_mh, g_qm):
    B, S, _ = x.shape
    h = rms_norm(x, g_norm)
    z = jnp.einsum('bsd,de->bse', h, w_in)
    qa, ka, va, ga, qb, kb, vb, ob, ib, fb, gb, qm, gm = split_cols(z)

    qa = rms_norm(qa.reshape(B, S, H_A, 2, DK_A), g_qa)
    ka = rms_norm(ka.reshape(B, S, H_A, 2, DK_A), g_ka)
    va = va.reshape(B, S, H_A, DV_A)
    new_k = ka.reshape(B, S, H_A, 2 * DK_A)
    if past_k is None:
        keys, vals, k_pos = ka, va, q_pos
    else:
        P = past_k.shape[1]
        keys = jnp.concatenate([past_k.reshape(B, P, H_A, 2, DK_A).astype(ka.dtype), ka], axis=1)
        vals = jnp.concatenate([past_v.astype(va.dtype), va], axis=1)
        k_pos = jnp.arange(P + S, dtype=jnp.int32)
    lam = (jnp.exp(jnp.sum(lam_q1.astype(F32) * lam_k1.astype(F32)))
           - jnp.exp(jnp.sum(lam_q2.astype(F32) * lam_k2.astype(F32))) + lam_init)
    oa = diff_attention(qa, keys, vals, q_pos, k_pos, lam)
    oa = rms_norm(oa, g_subln) * (1.0 - lam_init)
    oa = oa.reshape(B, S, W_A) * jax.nn.silu(ga)

    qb = qb.reshape(B, S, H_B, DH_B)
    kb = kb.reshape(B, S, H_B, DH_B) * (DH_B ** -0.5)
    vb = vb.reshape(B, S, H_B, DH_B)
    ig = (ib + b_i).astype(F32)
    lf = jax.nn.log_sigmoid((fb + b_f).astype(F32))
    hb, new_state = mlstm_run(qb, kb, vb, ig, lf, mlstm_state)
    hb = rms_norm(hb.astype(x.dtype), g_mh) * jax.nn.sigmoid(ob.reshape(B, S, H_B, DH_B))
    hb = hb.reshape(B, S, W_B) * jax.nn.silu(gb)

    qm = rms_norm(qm.reshape(B, S, H_M, DH_M), g_qm)
    sm = jnp.einsum('bshd,bnhd->bhsn', qm, mem_k.astype(qm.dtype), preferred_element_type=F32) * (DH_M ** -0.5)
    pm = jax.nn.softmax(sm, axis=-1)
    om = jnp.einsum('bhsn,bnhd->bshd', pm.astype(x.dtype), mem_v.astype(x.dtype)).reshape(B, S, W_M)
    om = om * jax.nn.silu(gm)

    mix = jnp.concatenate([oa, hb, om], axis=-1)
    y = x + jnp.einsum('bse,ed->bsd', mix, w_out)
    return y, new_k, va, new_state


def setup_inputs(seed: int = 0) -> dict:
    key = jax.random.key(seed)
    ks = iter(jax.random.split(key, 40))

    def nrm(shape, s=1.0):
        return s * jax.random.normal(next(ks), shape, F32)

    def gain(shape):
        return 1.0 + 0.05 * jax.random.normal(next(ks), shape, F32)

    return {
        "x_prompt": nrm((BATCH, SEQ, D_MODEL)),
        "x_sample": nrm((DEC_BATCH, DEC_SEQ, D_MODEL)),
        "cache_attn_k": nrm((DEPTH, DEC_BATCH, PAST_LEN, H_A, 2 * DK_A)),
        "cache_attn_v": nrm((DEPTH, DEC_BATCH, PAST_LEN, H_A, DV_A)),
        "state_mlstm_C": nrm((DEPTH, DEC_BATCH, H_B, DH_B, DH_B), 0.1),
        "state_mlstm_n": nrm((DEPTH, DEC_BATCH, H_B, DH_B), 0.1),
        "state_mlstm_m": nrm((DEPTH, DEC_BATCH, H_B), 0.5),
        "cache_mem_k": nrm((DEPTH, DEC_BATCH, N_MEM, H_M, DH_M)),
        "cache_mem_v": nrm((DEPTH, DEC_BATCH, N_MEM, H_M, DH_M)),
        "mem_prompt": nrm((BATCH, N_MEM, D_MODEL)),
        "g_norm": gain((DEPTH, D_MODEL)),
        "w_in": nrm((DEPTH, D_MODEL, N_IN), D_MODEL ** -0.5),
        "w_out": nrm((DEPTH, D_MIX, D_MODEL), D_MIX ** -0.5),
        "g_qa": gain((DEPTH, DK_A)),
        "g_ka": gain((DEPTH, DK_A)),
        "lam_q1": nrm((DEPTH, DK_A), 0.1),
        "lam_k1": nrm((DEPTH, DK_A), 0.1),
        "lam_q2": nrm((DEPTH, DK_A), 0.1),
        "lam_k2": nrm((DEPTH, DK_A), 0.1),
        "g_subln": gain((DEPTH, DV_A)),
        "b_i": nrm((DEPTH, H_B), 0.1),
        "b_f": jnp.linspace(3.0, 6.0, H_B, dtype=F32)[None, :] + nrm((DEPTH, H_B), 0.1),
        "g_mh": gain((DEPTH, DH_B)),
        "g_qm": gain((DEPTH, DH_M)),
        "g_km": gain((DEPTH, DH_M)),
        "g_mem": gain((DEPTH, D_MODEL)),
        "w_mk": nrm((DEPTH, D_MODEL, W_M), D_MODEL ** -0.5),
        "w_mv": nrm((DEPTH, D_MODEL, W_M), D_MODEL ** -0.5),
    }


def reference(x_prompt, x_sample, cache_attn_k, cache_attn_v, state_mlstm_C, state_mlstm_n,
              state_mlstm_m, cache_mem_k, cache_mem_v, mem_prompt, g_norm, w_in, w_out, g_qa,
              g_ka, lam_q1, lam_k1, lam_q2, lam_k2, g_subln, b_i, b_f, g_mh, g_qm, g_km, g_mem,
              w_mk, w_mv):
    Bp, Sp = x_prompt.shape[0], x_prompt.shape[1]
    Ss = x_sample.shape[1]
    P = cache_attn_k.shape[2]
    pos_p = jnp.arange(Sp, dtype=jnp.int32)
    pos_s = P + jnp.arange(Ss, dtype=jnp.int32)
    xp, xs = x_prompt, x_sample
    pk, pv, pC, pn, pm, pmk, pmv = [], [], [], [], [], [], []
    sk, sv, sC, sn, sm = [], [], [], [], []
    for l in range(DEPTH):
        lam_init = 0.8 - 0.6 * math.exp(-0.3 * l)
        w = (g_norm[l], w_in[l], w_out[l], g_qa[l], g_ka[l], lam_q1[l], lam_k1[l], lam_q2[l],
             lam_k2[l], g_subln[l], b_i[l], b_f[l], g_mh[l], g_qm[l])
        mk, mv = memory_kv(mem_prompt, g_mem[l], w_mk[l], w_mv[l], g_km[l])
        zero_state = (jnp.zeros((Bp, H_B, DH_B, DH_B), F32), jnp.zeros((Bp, H_B, DH_B), F32),
                      jnp.zeros((Bp, H_B), F32))
        xp, k_p, v_p, st_p = mixer_layer(xp, pos_p, None, None, zero_state, mk, mv, lam_init, *w)
        xs, k_s, v_s, st_s = mixer_layer(
            xs, pos_s, cache_attn_k[l], cache_attn_v[l],
            (state_mlstm_C[l], state_mlstm_n[l], state_mlstm_m[l]),
            cache_mem_k[l], cache_mem_v[l], lam_init, *w)
        pk.append(k_p); pv.append(v_p)
        pC.append(st_p[0].astype(x_prompt.dtype)); pn.append(st_p[1].astype(x_prompt.dtype))
        pm.append(st_p[2].astype(x_prompt.dtype))
        pmk.append(mk); pmv.append(mv)
        sk.append(k_s); sv.append(v_s)
        sC.append(st_s[0].astype(state_mlstm_C.dtype)); sn.append(st_s[1].astype(state_mlstm_n.dtype))
        sm.append(st_s[2].astype(state_mlstm_m.dtype))
    return (xp, xs, jnp.stack(pk), jnp.stack(pv), jnp.stack(pC), jnp.stack(pn), jnp.stack(pm),
            jnp.stack(pmk), jnp.stack(pmv), jnp.stack(sk), jnp.stack(sv), jnp.stack(sC),
            jnp.stack(sn), jnp.stack(sm))
```

```cpp
#include <hip/hip_runtime.h>
#include <hip/hip_cooperative_groups.h>
#include <cstdio>
namespace cg = cooperative_groups;

typedef unsigned short u16;
typedef short bf16x8 __attribute__((ext_vector_type(8)));
typedef short s16x4 __attribute__((ext_vector_type(4)));
typedef float f32x4 __attribute__((ext_vector_type(4)));
typedef float f32x2 __attribute__((ext_vector_type(2)));
typedef __bf16 bf16x2_t __attribute__((ext_vector_type(2)));
#define DI __device__ __forceinline__
#define MFMA(a, b, c) __builtin_amdgcn_mfma_f32_16x16x32_bf16((a), (b), (c), 0, 0, 0)

constexpr int DM = 1024;
constexpr int TP = 65536;
constexpr int TS = 128;
constexpr int TMEM = 8192;
constexpr int NZ = 3840;
constexpr int NIN = 3848;
constexpr int SKS = 2064;
constexpr float EPS = 1e-6f;
constexpr float LOG2E = 1.4426950408889634f;
constexpr float QSCALE = 0.125f * LOG2E;

constexpr size_t WS_CTL = 0;
constexpr size_t WS_WTIN = 4096;
constexpr size_t WS_WTOUT = WS_WTIN + (size_t)NZ * 1024 * 2;
constexpr size_t WS_WTM = WS_WTOUT + (size_t)1024 * 1024 * 2;
constexpr size_t WS_XB = WS_WTM + (size_t)512 * 1024 * 2;
constexpr size_t WS_XSB = WS_XB + (size_t)TP * 1024 * 2;
constexpr size_t WS_MB = WS_XSB + (size_t)TS * 1024 * 2;
constexpr size_t WS_RSTD = WS_MB + (size_t)TMEM * 1024 * 2;
constexpr size_t WS_RSTDS = WS_RSTD + (size_t)TP * 4;
constexpr size_t WS_RSTDM = WS_RSTDS + (size_t)TS * 4;
constexpr size_t WS_GIF = WS_RSTDM + (size_t)TMEM * 4;
constexpr size_t WS_GIFS = WS_GIF + (size_t)TP * 8 * 4;
constexpr size_t WS_Z = WS_GIFS + (size_t)TS * 8 * 4;
constexpr size_t WS_ZS = WS_Z + (size_t)TP * NZ * 2;
constexpr size_t WS_MIX = WS_ZS + (size_t)TS * NZ * 2;
constexpr size_t WS_MIXS = WS_MIX + (size_t)TP * 1024 * 2;
constexpr size_t WS_KS = WS_MIXS + (size_t)TS * 1024 * 2;
constexpr size_t WS_VS = WS_KS + (size_t)8 * SKS * 512 * 2;
constexpr size_t WS_MKV = WS_VS + (size_t)8 * SKS * 512 * 2;
constexpr size_t WS_MKVS = WS_MKV + (size_t)TMEM * 512 * 2;
constexpr size_t WS_END = WS_MKVS + (size_t)2048 * 512 * 2;

constexpr long O_Y = 0;
constexpr long O_YS = O_Y + 67108864L;
constexpr long O_PK = O_YS + 131072L;
constexpr long O_PV = O_PK + 33554432L;
constexpr long O_PC = O_PV + 33554432L;
constexpr long O_PN = O_PC + 524288L;
constexpr long O_PM = O_PN + 8192L;
constexpr long O_PMK = O_PM + 128L;
constexpr long O_PMV = O_PMK + 2097152L;
constexpr long O_SK = O_PMV + 2097152L;
constexpr long O_SV = O_SK + 65536L;
constexpr long O_SC = O_SV + 65536L;
constexpr long O_SN = O_SC + 131072L;
constexpr long O_SM = O_SN + 2048L;

constexpr int LDS_BYTES = 98304;

struct Params {
  const float* x; const float* xs; const float* ck; const float* cv; const float* sC; const float* sN; const float* sM;
  const float* cmk; const float* cmv; const float* mem; const float* g_norm; const float* w_in; const float* w_out;
  const float* g_qa; const float* g_ka; const float* lq1; const float* lk1; const float* lq2; const float* lk2;
  const float* g_subln; const float* b_i; const float* b_f; const float* g_mh; const float* g_qm; const float* g_km;
  const float* g_mem; const float* w_mk; const float* w_mv;
  float* out; char* ws;
};

DI unsigned pack2(float a, float b) { f32x2 v = {a, b}; return __builtin_bit_cast(unsigned, __builtin_convertvector(v, bf16x2_t)); }
DI float bf_lo(unsigned u) { return __uint_as_float(u << 16); }
DI float bf_hi(unsigned u) { return __uint_as_float(u & 0xffff0000u); }
DI float ex2(float x) { return __builtin_amdgcn_exp2f(x); }
DI bf16x8 ld_frag(const char* p) { return __builtin_bit_cast(bf16x8, *(const uint4*)p); }
DI bf16x8 mk_frag(unsigned a, unsigned b, unsigned c, unsigned d) { uint4 v = {a, b, c, d}; return __builtin_bit_cast(bf16x8, v); }
DI uint2 tr_read(const char* p) {
  s16x4 r = __builtin_amdgcn_ds_read_tr16_b64_v4i16((__attribute__((address_space(3))) s16x4*)(p));
  return __builtin_bit_cast(uint2, r);
}
DI bf16x8 tr_frag(const char* p, int off2) { uint2 a = tr_read(p), b = tr_read(p + off2); return mk_frag(a.x, a.y, b.x, b.y); }
DI float wave_sum(float v) {
#pragma unroll
  for (int o = 32; o > 0; o >>= 1) v += __shfl_xor(v, o);
  return v;
}
DI float silu_f(float x) { return x / (1.f + __expf(-x)); }
DI float sigm_f(float x) { return 1.f / (1.f + __expf(-x)); }

DI void phase0(const Params& p, char* smem) {
  const int tid = threadIdx.x, lane = tid & 63, wave = tid >> 6;
  char* ws = p.ws;
  if (blockIdx.x == 0 && wave == 0) {
    float a = wave_sum(p.lq1[lane] * p.lk1[lane]);
    float b = wave_sum(p.lq2[lane] * p.lk2[lane]);
    if (lane == 0) {
      ((int*)(ws + WS_CTL))[4] = 0; ((int*)(ws + WS_CTL))[8] = 0; ((int*)(ws + WS_CTL))[12] = 0;
      ((float*)(ws + WS_CTL))[1] = expf(a) - expf(b) + 0.2f;
    }
  }
  float* WG = (float*)smem;
  for (int k = tid; k < 1024; k += 256) {
    float g = p.g_norm[k];
    float4 a = *(const float4*)(p.w_in + (long)k * NIN + 3072);
    float4 b = *(const float4*)(p.w_in + (long)k * NIN + 3076);
    float4 a2 = {a.x * g, a.y * g, a.z * g, a.w * g}, b2 = {b.x * g, b.y * g, b.z * g, b.w * g};
    *(float4*)(WG + k * 8) = a2; *(float4*)(WG + k * 8 + 4) = b2;
  }
  __syncthreads();
  {
    const int gw = blockIdx.x * 4 + wave, nw = gridDim.x * 4;
    for (int r = gw; r < TP + TS + TMEM; r += nw) {
      const float* src; u16* dst; float* rs; float* gif;
      if (r < TP) { src = p.x + (long)r * 1024; dst = (u16*)(ws + WS_XB) + (long)r * 1024; rs = (float*)(ws + WS_RSTD) + r; gif = (float*)(ws + WS_GIF) + (long)r * 8; }
      else if (r < TP + TS) { int q = r - TP; src = p.xs + (long)q * 1024; dst = (u16*)(ws + WS_XSB) + (long)q * 1024; rs = (float*)(ws + WS_RSTDS) + q; gif = (float*)(ws + WS_GIFS) + (long)q * 8; }
      else { int q = r - TP - TS; src = p.mem + (long)q * 1024; dst = (u16*)(ws + WS_MB) + (long)q * 1024; rs = (float*)(ws + WS_RSTDM) + q; gif = nullptr; }
      float4 v[4];
#pragma unroll
      for (int i = 0; i < 4; ++i) v[i] = *(const float4*)(src + i * 256 + lane * 4);
      float ss = 0.f;
#pragma unroll
      for (int i = 0; i < 4; ++i) ss += v[i].x * v[i].x + v[i].y * v[i].y + v[i].z * v[i].z + v[i].w * v[i].w;
      ss = wave_sum(ss);
      const float rstd = rsqrtf(ss * (1.f / 1024.f) + EPS);
#pragma unroll
      for (int i = 0; i < 4; ++i) {
        uint2 o = {pack2(v[i].x, v[i].y), pack2(v[i].z, v[i].w)};
        *(uint2*)(dst + i * 256 + lane * 4) = o;
      }
      if (lane == 0) *rs = rstd;
      if (gif) {
        float g[8];
#pragma unroll
        for (int j = 0; j < 8; ++j) g[j] = 0.f;
#pragma unroll
        for (int i = 0; i < 4; ++i) {
          const float xv[4] = {v[i].x, v[i].y, v[i].z, v[i].w};
#pragma unroll
          for (int e = 0; e < 4; ++e) {
            const float* wr = WG + (i * 256 + lane * 4 + e) * 8;
            float4 wa = *(const float4*)wr, wb = *(const float4*)(wr + 4);
            g[0] += xv[e] * wa.x; g[1] += xv[e] * wa.y; g[2] += xv[e] * wa.z; g[3] += xv[e] * wa.w;
            g[4] += xv[e] * wb.x; g[5] += xv[e] * wb.y; g[6] += xv[e] * wb.z; g[7] += xv[e] * wb.w;
          }
        }
#pragma unroll
        for (int j = 0; j < 8; ++j) g[j] = wave_sum(g[j]);
        if (lane == 0) {
          float o[8];
#pragma unroll
          for (int j = 0; j < 4; ++j) o[j] = g[j] * rstd + p.b_i[j];
#pragma unroll
          for (int j = 0; j < 4; ++j) {
            float xx = g[4 + j] * rstd + p.b_f[j];
            o[4 + j] = fminf(xx, 0.f) - log1pf(expf(-fabsf(xx)));
          }
          float4 oa = {o[0], o[1], o[2], o[3]}, ob = {o[4], o[5], o[6], o[7]};
          *(float4*)gif = oa; *(float4*)(gif + 4) = ob;
        }
      }
    }
  }
  const long gtid = (long)blockIdx.x * 256 + tid, nth = (long)gridDim.x * 256;
  {
    u16* wt = (u16*)(ws + WS_WTIN);
    for (long idx = gtid; idx < (long)NZ * 128; idx += nth) {
      int n = (int)(idx % NZ), kc = (int)(idx / NZ);
      int on = n < 3072 ? n : n + 8;
      float v[8];
#pragma unroll
      for (int e = 0; e < 8; ++e) v[e] = p.w_in[(long)(kc * 8 + e) * NIN + on] * p.g_norm[kc * 8 + e];
      uint4 o = {pack2(v[0], v[1]), pack2(v[2], v[3]), pack2(v[4], v[5]), pack2(v[6], v[7])};
      *(uint4*)(wt + (long)n * 1024 + kc * 8) = o;
    }
    u16* wo = (u16*)(ws + WS_WTOUT);
    for (long idx = gtid; idx < 1024L * 128; idx += nth) {
      int n = (int)(idx % 1024), kc = (int)(idx / 1024);
      float v[8];
#pragma unroll
      for (int e = 0; e < 8; ++e) v[e] = p.w_out[(long)(kc * 8 + e) * 1024 + n];
      uint4 o = {pack2(v[0], v[1]), pack2(v[2], v[3]), pack2(v[4], v[5]), pack2(v[6], v[7])};
      *(uint4*)(wo + (long)n * 1024 + kc * 8) = o;
    }
    u16* wm = (u16*)(ws + WS_WTM);
    for (long idx = gtid; idx < 512L * 128; idx += nth) {
      int n = (int)(idx % 512), kc = (int)(idx / 512);
      const float* src = n < 256 ? p.w_mk + n : p.w_mv + (n - 256);
      float v[8];
#pragma unroll
      for (int e = 0; e < 8; ++e) v[e] = src[(long)(kc * 8 + e) * 256] * p.g_mem[kc * 8 + e];
      uint4 o = {pack2(v[0], v[1]), pack2(v[2], v[3]), pack2(v[4], v[5]), pack2(v[6], v[7])};
      *(uint4*)(wm + (long)n * 1024 + kc * 8) = o;
    }
  }
  {
    u16* ks = (u16*)(ws + WS_KS); u16* vs = (u16*)(ws + WS_VS);
    for (long idx = gtid; idx < 2L * 8 * 2048 * 64; idx += nth) {
      long id = idx; const float* srcb = p.ck; u16* dstb = ks;
      if (id >= 8L * 2048 * 64) { id -= 8L * 2048 * 64; srcb = p.cv; dstb = vs; }
      int c = (int)(id & 63); long row = id >> 6; int b = (int)(row >> 11); int rr = (int)(row & 2047);
      const float* s = srcb + row * 512 + c * 8;
      float4 a = *(const float4*)s, bb = *(const float4*)(s + 4);
      uint4 o = {pack2(a.x, a.y), pack2(a.z, a.w), pack2(bb.x, bb.y), pack2(bb.z, bb.w)};
      *(uint4*)(dstb + ((long)b * SKS + rr) * 512 + c * 8) = o;
    }
    u16* mk = (u16*)(ws + WS_MKVS);
    for (long idx = gtid; idx < 2L * 2048 * 32; idx += nth) {
      long id = idx; const float* srcb = p.cmk; int coff = 0;
      if (id >= 2048L * 32) { id -= 2048L * 32; srcb = p.cmv; coff = 256; }
      int c = (int)(id & 31); long row = id >> 5;
      const float* s = srcb + row * 256 + c * 8;
      float4 a = *(const float4*)s, bb = *(const float4*)(s + 4);
      uint4 o = {pack2(a.x, a.y), pack2(a.z, a.w), pack2(bb.x, bb.y), pack2(bb.z, bb.w)};
      *(uint4*)(mk + row * 512 + coff + c * 8) = o;
    }
  }
}

struct EpiCfg {
  const float* rs; const float* gain; float post; int act;
  float* o32; long ld32; int c32;
  u16* ob; long ldb; int cb;
  u16* ob2; int c2;
  const float* resid;
};

DI void gemm_mainloop(const u16* __restrict__ A, int M, const u16* __restrict__ W, int m0, int n0, char* smem, f32x4 (&acc)[4][8]) {
  const int tid = threadIdx.x, lane = tid & 63, wave = tid >> 6;
  const int l15 = lane & 15, quad = lane >> 4, l7 = lane & 7;
  const int wm = wave & 1, wn = wave >> 1;
  const int c8 = tid & 7, r0 = tid >> 3;
#pragma unroll
  for (int a = 0; a < 4; ++a)
#pragma unroll
    for (int b = 0; b < 8; ++b) acc[a][b] = (f32x4){0.f, 0.f, 0.f, 0.f};
  uint4 ra[8], rw[4];
  const int st_off = r0 * 128 + ((c8 ^ (r0 & 7)) * 16);
  auto loadk = [&](int kt) {
#pragma unroll
    for (int i = 0; i < 8; ++i) {
      int row = m0 + r0 + 32 * i; row = row < M ? row : M - 1;
      ra[i] = *(const uint4*)(A + (long)row * 1024 + kt * 64 + c8 * 8);
    }
#pragma unroll
    for (int i = 0; i < 4; ++i) rw[i] = *(const uint4*)(W + (long)(n0 + r0 + 32 * i) * 1024 + kt * 64 + c8 * 8);
  };
  auto storek = [&](int stage) {
    char* sa = smem + stage * 49152; char* sw = sa + 32768;
#pragma unroll
    for (int i = 0; i < 8; ++i) *(uint4*)(sa + st_off + i * 4096) = ra[i];
#pragma unroll
    for (int i = 0; i < 4; ++i) *(uint4*)(sw + st_off + i * 4096) = rw[i];
  };
  loadk(0); storek(0); __syncthreads();
  for (int kt = 0; kt < 16; ++kt) {
    if (kt + 1 < 16) loadk(kt + 1);
    const char* sa = smem + (kt & 1) * 49152; const char* sw = sa + 32768;
#pragma unroll
    for (int ks = 0; ks < 2; ++ks) {
      const int sw_off = ((ks * 4 + quad) ^ l7) * 16;
      bf16x8 wf[4], tf[8];
#pragma unroll
      for (int fi = 0; fi < 4; ++fi) wf[fi] = ld_frag(sw + (wn * 64 + fi * 16 + l15) * 128 + sw_off);
#pragma unroll
      for (int ti = 0; ti < 8; ++ti) tf[ti] = ld_frag(sa + (wm * 128 + ti * 16 + l15) * 128 + sw_off);
#pragma unroll
      for (int fi = 0; fi < 4; ++fi)
#pragma unroll
        for (int ti = 0; ti < 8; ++ti) acc[fi][ti] = MFMA(wf[fi], tf[ti], acc[fi][ti]);
    }
    if (kt + 1 < 16) storek((kt + 1) & 1);
    __syncthreads();
  }
}

DI void gemm_epilogue(const EpiCfg& e, int M, int m0, f32x4 (&acc)[4][8]) {
  const int lane = threadIdx.x & 63, wave = threadIdx.x >> 6;
  const int l15 = lane & 15, quad = lane >> 4;
  const int wm = wave & 1;
  float gn[4][4];
  if (e.gain) {
#pragma unroll
    for (int fi = 0; fi < 4; ++fi) { float4 g = *(const float4*)(e.gain + fi * 16 + quad * 4); gn[fi][0] = g.x; gn[fi][1] = g.y; gn[fi][2] = g.z; gn[fi][3] = g.w; }
  }
#pragma unroll
  for (int ti = 0; ti < 8; ++ti) {
    const int tok = m0 + wm * 128 + ti * 16 + l15;
    const bool valid = tok < M;
    const int tokc = valid ? tok : M - 1;
    float v[4][4];
    const float rs = e.rs ? e.rs[tokc] : 1.f;
#pragma unroll
    for (int fi = 0; fi < 4; ++fi)
#pragma unroll
      for (int j = 0; j < 4; ++j) v[fi][j] = acc[fi][ti][j] * rs;
    if (e.gain) {
      float ss = 0.f;
#pragma unroll
      for (int fi = 0; fi < 4; ++fi)
#pragma unroll
        for (int j = 0; j < 4; ++j) ss += v[fi][j] * v[fi][j];
      ss += __shfl_xor(ss, 16); ss += __shfl_xor(ss, 32);
      const float r = rsqrtf(ss * (1.f / 64.f) + EPS);
#pragma unroll
      for (int fi = 0; fi < 4; ++fi)
#pragma unroll
        for (int j = 0; j < 4; ++j) v[fi][j] *= r * gn[fi][j];
    }
    if (e.resid && valid) {
#pragma unroll
      for (int fi = 0; fi < 4; ++fi) {
        float4 x4 = *(const float4*)(e.resid + (long)tok * 1024 + e.c32 + fi * 16 + quad * 4);
        v[fi][0] += x4.x; v[fi][1] += x4.y; v[fi][2] += x4.z; v[fi][3] += x4.w;
      }
    }
    if (e.o32 && valid) {
#pragma unroll
      for (int fi = 0; fi < 4; ++fi) {
        float4 o = {v[fi][0], v[fi][1], v[fi][2], v[fi][3]};
        *(float4*)(e.o32 + (long)tok * e.ld32 + e.c32 + fi * 16 + quad * 4) = o;
      }
    }
    if (e.ob) {
#pragma unroll
      for (int fi = 0; fi < 4; ++fi)
#pragma unroll
        for (int j = 0; j < 4; ++j) {
          float t = v[fi][j] * e.post;
          if (e.act == 1) t = silu_f(t); else if (e.act == 2) t = sigm_f(t);
          v[fi][j] = t;
        }
      if (valid) {
#pragma unroll
        for (int fi = 0; fi < 4; ++fi) {
          uint2 o = {pack2(v[fi][0], v[fi][1]), pack2(v[fi][2], v[fi][3])};
          *(uint2*)(e.ob + (long)tok * e.ldb + e.cb + fi * 16 + quad * 4) = o;
          if (e.ob2) {
            long row2 = (long)(tok >> 4) * SKS + 2048 + (tok & 15);
            *(uint2*)(e.ob2 + row2 * 512 + e.c2 + fi * 16 + quad * 4) = o;
          }
        }
      }
    }
  }
}

DI EpiCfg epi_inproj(const Params& p, int gidx, bool sample) {
  char* ws = p.ws;
  EpiCfg e{};
  e.rs = (const float*)(ws + (sample ? WS_RSTDS : WS_RSTD));
  e.post = 1.f; e.act = 0;
  e.ob = (u16*)(ws + (sample ? WS_ZS : WS_Z)); e.ldb = NZ; e.cb = gidx * 64;
  if (gidx < 8) { e.gain = p.g_qa; e.post = QSCALE; }
  else if (gidx < 16) {
    e.gain = p.g_ka; e.o32 = p.out + (sample ? O_SK : O_PK); e.ld32 = 512; e.c32 = (gidx - 8) * 64;
    if (sample) { e.ob2 = (u16*)(ws + WS_KS); e.c2 = (gidx - 8) * 64; }
  } else if (gidx < 24) {
    e.o32 = p.out + (sample ? O_SV : O_PV); e.ld32 = 512; e.c32 = (gidx - 16) * 64;
    if (sample) { e.ob2 = (u16*)(ws + WS_VS); e.c2 = (gidx - 16) * 64; }
  } else if (gidx < 32) { e.act = 1; }
  else if (gidx < 36) { }
  else if (gidx < 40) { e.post = 0.125f; }
  else if (gidx < 44) { }
  else if (gidx < 48) { e.act = 2; }
  else if (gidx < 52) { e.act = 1; }
  else if (gidx < 56) { e.gain = p.g_qm; e.post = QSCALE; }
  else { e.act = 1; }
  return e;
}

DI void phase1(const Params& p, char* smem) {
  char* ws = p.ws;
  const int wn = threadIdx.x >> 7;
  constexpr int T_MAIN = 256 * 30, T_MEM = 32 * 4, T_S = 30;
  for (int t = blockIdx.x; t < T_MAIN + T_MEM + T_S; t += gridDim.x) {
    f32x4 acc[4][8];
    if (t < T_MAIN) {
      const int mt = t / 30, nt = t % 30;
      gemm_mainloop((const u16*)(ws + WS_XB), TP, (const u16*)(ws + WS_WTIN), mt * 256, nt * 128, smem, acc);
      EpiCfg e = epi_inproj(p, nt * 2 + wn, false);
      gemm_epilogue(e, TP, mt * 256, acc);
    } else if (t < T_MAIN + T_MEM) {
      const int u = t - T_MAIN; const int mt = u / 4, nt = u % 4;
      gemm_mainloop((const u16*)(ws + WS_MB), TMEM, (const u16*)(ws + WS_WTM), mt * 256, nt * 128, smem, acc);
      const int gidx = nt * 2 + wn;
      EpiCfg e{};
      e.rs = (const float*)(ws + WS_RSTDM); e.post = 1.f;
      e.gain = gidx < 4 ? p.g_km : nullptr;
      e.o32 = p.out + (gidx < 4 ? O_PMK : O_PMV); e.ld32 = 256; e.c32 = (gidx & 3) * 64;
      e.ob = (u16*)(ws + WS_MKV); e.ldb = 512; e.cb = gidx * 64;
      gemm_epilogue(e, TMEM, mt * 256, acc);
    } else {
      const int nt = t - T_MAIN - T_MEM;
      gemm_mainloop((const u16*)(ws + WS_XSB), TS, (const u16*)(ws + WS_WTIN), 0, nt * 128, smem, acc);
      EpiCfg e = epi_inproj(p, nt * 2 + wn, true);
      gemm_epilogue(e, TS, 0, acc);
    }
  }
}

DI void phase3(const Params& p, char* smem) {
  char* ws = p.ws;
  const int wn = threadIdx.x >> 7;
  constexpr int T_MAIN = 256 * 8, T_S = 8;
  for (int t = blockIdx.x; t < T_MAIN + T_S; t += gridDim.x) {
    f32x4 acc[4][8];
    EpiCfg e{};
    e.post = 1.f; e.ld32 = 1024;
    if (t < T_MAIN) {
      const int mt = t / 8, nt = t % 8;
      gemm_mainloop((const u16*)(ws + WS_MIX), TP, (const u16*)(ws + WS_WTOUT), mt * 256, nt * 128, smem, acc);
      e.resid = p.x; e.o32 = p.out + O_Y; e.c32 = nt * 128 + wn * 64;
      gemm_epilogue(e, TP, mt * 256, acc);
    } else {
      const int nt = t - T_MAIN;
      gemm_mainloop((const u16*)(ws + WS_MIXS), TS, (const u16*)(ws + WS_WTOUT), 0, nt * 128, smem, acc);
      e.resid = p.xs; e.o32 = p.out + O_YS; e.c32 = nt * 128 + wn * 64;
      gemm_epilogue(e, TS, 0, acc);
    }
  }
}

struct AttnArgs {
  const u16* Q; long ldq; int nq;
  const u16* K; const u16* V; long ldk; long ldv; int nkeys;
  int ntile_lo, ntile_hi;
  int qpos0; float slope2; float lam;
  const u16* gate; long ldg;
  u16* out; long ldo;
  const float* gsub;
};

struct AttnLocal {
  const u16* Q; long ldq; int nq;
  const u16* K; const u16* V; long ldk; long ldv; int nkeys;
  int ntile_lo, ntile_hi;
  int qpos0; float slope2; float lam;
  const u16* gate; long ldg;
  u16* out; long ldo;
  const float* gsub;
};
template <int NMAP, int DV, bool ALIBI>
DI void attn_item(const u16* aQ, long aldq, int anq, const u16* aK, const u16* aV, long aldk, long aldv, int ankeys,
                  int antile_lo, int antile_hi, int aqpos0, float aslope2, float alam, const u16* agate, long aldg,
                  u16* aout, long aldo, const float* agsub, char* smem) {
  const int tid = threadIdx.x, lane = tid & 63, w = tid >> 6;
  const int l15 = lane & 15, quad = lane >> 4, l7 = lane & 7;
  constexpr int KB = NMAP * 8192;
  constexpr int VSTR = DV * 2 + 32;
  constexpr int VB = 64 * VSTR;
  constexpr int STG = KB + VB;
  constexpr int NKC = NMAP * 2;
  constexpr int NVC = DV / 32;
  constexpr int NDT = DV / 16;
  constexpr int VCR = DV / 8;

  bf16x8 qf[NMAP][2][2];
#pragma unroll
  for (int m = 0; m < NMAP; ++m)
#pragma unroll
    for (int ks = 0; ks < 2; ++ks)
#pragma unroll
      for (int qt = 0; qt < 2; ++qt) {
        int row = w * 32 + qt * 16 + l15; row = row < anq ? row : anq - 1;
        qf[m][ks][qt] = __builtin_bit_cast(bf16x8, *(const uint4*)(aQ + (long)row * aldq + m * 64 + ks * 32 + quad * 8));
      }
  f32x4 O[NMAP][NDT][2];
  float mrun[NMAP][2], lrun[NMAP][2];
#pragma unroll
  for (int m = 0; m < NMAP; ++m)
#pragma unroll
    for (int qt = 0; qt < 2; ++qt) {
      mrun[m][qt] = -INFINITY; lrun[m][qt] = 0.f;
#pragma unroll
      for (int dt = 0; dt < NDT; ++dt) O[m][dt][qt] = (f32x4){0.f, 0.f, 0.f, 0.f};
    }
  const int ntile = antile_hi;
  const int myt = (w < 2) ? antile_lo : antile_hi;
  uint4 rk[NKC], rv[NVC];
  auto loadt = [&](int t) {
#pragma unroll
    for (int i = 0; i < NKC; ++i) {
      int id = tid + 256 * i; int key = id / (NMAP * 8), cc = id % (NMAP * 8);
      int kr = t * 64 + key; kr = kr < ankeys ? kr : ankeys - 1;
      rk[i] = *(const uint4*)(aK + (long)kr * aldk + cc * 8);
    }
#pragma unroll
    for (int i = 0; i < NVC; ++i) {
      int id = tid + 256 * i; int key = id / VCR, c = id % VCR;
      int kr = t * 64 + key; kr = kr < ankeys ? kr : ankeys - 1;
      rv[i] = *(const uint4*)(aV + (long)kr * aldv + c * 8);
    }
  };
  auto storet = [&](int stage) {
    char* kb = smem + stage * STG; char* vb = kb + KB;
#pragma unroll
    for (int i = 0; i < NKC; ++i) {
      int id = tid + 256 * i; int key = id / (NMAP * 8), cc = id % (NMAP * 8);
      int m = cc >> 3, c = cc & 7;
      *(uint4*)(kb + m * 8192 + key * 128 + ((c ^ (key & 7)) * 16)) = rk[i];
    }
#pragma unroll
    for (int i = 0; i < NVC; ++i) {
      int id = tid + 256 * i; int key = id / VCR, c = id % VCR;
      *(uint4*)(vb + key * VSTR + c * 16) = rv[i];
    }
  };
  const int q4 = l15 >> 2, p4 = l15 & 3;
  loadt(0); storet(0); __syncthreads();
  for (int t = 0; t < ntile; ++t) {
    loadt(t + 1 < ntile ? t + 1 : t);
    {
      const char* kb = smem + (t & 1) * STG; const char* vb = kb + KB;
      unsigned pf[NMAP][2][2][4];
      const bool partial = ((t + 1) * 64 > ankeys) || (t >= myt);
      const int klim = (t >= myt) ? 0 : ankeys;
#pragma unroll
      for (int m = 0; m < NMAP; ++m) {
        f32x4 s[4][2];
#pragma unroll
        for (int kt = 0; kt < 4; ++kt) {
          const char* kr = kb + m * 8192 + (kt * 16 + l15) * 128;
          bf16x8 k0 = ld_frag(kr + ((quad ^ l7) * 16));
          bf16x8 k1 = ld_frag(kr + (((4 + quad) ^ l7) * 16));
#pragma unroll
          for (int qt = 0; qt < 2; ++qt) {
            f32x4 z = {0.f, 0.f, 0.f, 0.f};
            z = MFMA(k0, qf[m][0][qt], z);
            s[kt][qt] = MFMA(k1, qf[m][1][qt], z);
          }
        }
        if (ALIBI) {
#pragma unroll
          for (int qt = 0; qt < 2; ++qt) {
            const float dq = (float)(aqpos0 + w * 32 + qt * 16 + l15 - t * 64 - quad * 4);
#pragma unroll
            for (int kt = 0; kt < 4; ++kt)
#pragma unroll
              for (int j = 0; j < 4; ++j) s[kt][qt][j] = fmaf(-aslope2, fabsf(dq - (float)(kt * 16 + j)), s[kt][qt][j]);
          }
        }
        if (partial) {
#pragma unroll
          for (int kt = 0; kt < 4; ++kt)
#pragma unroll
            for (int j = 0; j < 4; ++j) {
              const bool bad = (t * 64 + kt * 16 + quad * 4 + j) >= klim;
#pragma unroll
              for (int qt = 0; qt < 2; ++qt) s[kt][qt][j] = bad ? -INFINITY : s[kt][qt][j];
            }
        }
#pragma unroll
        for (int qt = 0; qt < 2; ++qt) {
          float mx = -INFINITY;
#pragma unroll
          for (int kt = 0; kt < 4; ++kt)
#pragma unroll
            for (int j = 0; j < 4; ++j) mx = fmaxf(mx, s[kt][qt][j]);
          mx = fmaxf(mx, __shfl_xor(mx, 16)); mx = fmaxf(mx, __shfl_xor(mx, 32));
          const float mnew = fmaxf(mrun[m][qt], mx);
          const float alpha = ex2(mrun[m][qt] - mnew);
          mrun[m][qt] = mnew;
          float psum = 0.f;
#pragma unroll
          for (int kt = 0; kt < 4; ++kt)
#pragma unroll
            for (int j = 0; j < 4; ++j) { float pv = ex2(s[kt][qt][j] - mnew); psum += pv; s[kt][qt][j] = pv; }
          lrun[m][qt] = lrun[m][qt] * alpha + psum;
#pragma unroll
          for (int dt = 0; dt < NDT; ++dt) O[m][dt][qt] *= alpha;
#pragma unroll
          for (int ks2 = 0; ks2 < 2; ++ks2) {
            pf[m][ks2][qt][0] = pack2(s[2 * ks2][qt][0], s[2 * ks2][qt][1]);
            pf[m][ks2][qt][1] = pack2(s[2 * ks2][qt][2], s[2 * ks2][qt][3]);
            pf[m][ks2][qt][2] = pack2(s[2 * ks2 + 1][qt][0], s[2 * ks2 + 1][qt][1]);
            pf[m][ks2][qt][3] = pack2(s[2 * ks2 + 1][qt][2], s[2 * ks2 + 1][qt][3]);
          }
        }
      }
      const char* vl = vb + (quad * 4 + q4) * VSTR + p4 * 8;
#pragma unroll
      for (int ks2 = 0; ks2 < 2; ++ks2)
#pragma unroll
        for (int dt = 0; dt < NDT; ++dt) {
          bf16x8 vf = tr_frag(vl + ks2 * 32 * VSTR + dt * 32, 16 * VSTR);
#pragma unroll
          for (int m = 0; m < NMAP; ++m)
#pragma unroll
            for (int qt = 0; qt < 2; ++qt)
              O[m][dt][qt] = MFMA(vf, mk_frag(pf[m][ks2][qt][0], pf[m][ks2][qt][1], pf[m][ks2][qt][2], pf[m][ks2][qt][3]), O[m][dt][qt]);
        }
    }
    storet((t + 1) & 1);
    __syncthreads();
  }
#pragma unroll
  for (int qt = 0; qt < 2; ++qt) {
    float l0 = lrun[0][qt]; l0 += __shfl_xor(l0, 16); l0 += __shfl_xor(l0, 32);
    const float inv0 = 1.f / l0;
    float inv1 = 0.f;
    if (NMAP == 2) { float l1 = lrun[NMAP - 1][qt]; l1 += __shfl_xor(l1, 16); l1 += __shfl_xor(l1, 32); inv1 = alam / l1; }
    float ss = 0.f;
#pragma unroll
    for (int dt = 0; dt < NDT; ++dt)
#pragma unroll
      for (int j = 0; j < 4; ++j) {
        float o = O[0][dt][qt][j] * inv0;
        if (NMAP == 2) o -= O[NMAP - 1][dt][qt][j] * inv1;
        O[0][dt][qt][j] = o; ss += o * o;
      }
    float r = 1.f;
    if (NMAP == 2) {
      ss += __shfl_xor(ss, 16); ss += __shfl_xor(ss, 32);
      r = rsqrtf(ss * (1.f / DV) + EPS) * 0.8f;
    }
    const int row = w * 32 + qt * 16 + l15;
    if (row < anq) {
#pragma unroll
      for (int dt = 0; dt < NDT; ++dt) {
        const int col = dt * 16 + quad * 4;
        uint2 g = *(const uint2*)(agate + (long)row * aldg + col);
        float g0 = bf_lo(g.x), g1 = bf_hi(g.x), g2 = bf_lo(g.y), g3 = bf_hi(g.y);
        if (NMAP == 2) { float4 gs = *(const float4*)(agsub + col); g0 *= gs.x; g1 *= gs.y; g2 *= gs.z; g3 *= gs.w; }
        uint2 o = {pack2(O[0][dt][qt][0] * r * g0, O[0][dt][qt][1] * r * g1), pack2(O[0][dt][qt][2] * r * g2, O[0][dt][qt][3] * r * g3)};
        *(uint2*)(aout + (long)row * aldo + col) = o;
      }
    }
  }
}

struct MlstmArgs {
  const u16* Z; int nchunk; int nvalid;
  const float* gif;
  int h;
  const float* C0; const float* n0; float m0; bool has_state;
  u16* mix; long ldm;
  const float* g_mh;
  float* oC; float* oN; float* oM;
};

DI void mlstm_item(const u16* aZ, int anchunk, int anvalid, const float* agif, int ah, const float* aC0, const float* an0, float am0,
                   bool ahas_state, u16* amix, long aldm, const float* ag_mh, float* aoC, float* aoN, float* aoM, char* smem) {
  const int tid = threadIdx.x, lane = tid & 63, w = tid >> 6;
  const int l15 = lane & 15, quad = lane >> 4;
  const int q4 = l15 >> 2, p4 = l15 & 3;
  constexpr int RS = 160;
  constexpr int TB = 64 * RS;
  constexpr int STG = 3 * TB;
  char* ct = smem + 2 * STG;
  float* ga = (float*)(ct + 80 * RS);
  constexpr int GST = 5 * 64 + 4;
  const int h = ah;
  f32x4 Cacc[5];
#pragma unroll
  for (int dt = 0; dt < 5; ++dt) Cacc[dt] = (f32x4){0.f, 0.f, 0.f, 0.f};
  if (ahas_state) {
#pragma unroll
    for (int dt = 0; dt < 4; ++dt)
#pragma unroll
      for (int j = 0; j < 4; ++j) Cacc[dt][j] = aC0[(16 * w + quad * 4 + j) * 64 + dt * 16 + l15];
    if (l15 == 0) {
#pragma unroll
      for (int j = 0; j < 4; ++j) Cacc[4][j] = an0[16 * w + quad * 4 + j];
    }
  }
  auto write_ct = [&]() {
#pragma unroll
    for (int dt = 0; dt < 5; ++dt) {
      uint2 o = {pack2(Cacc[dt][0], Cacc[dt][1]), pack2(Cacc[dt][2], Cacc[dt][3])};
      *(uint2*)(ct + (dt * 16 + l15) * RS + (16 * w + quad * 4) * 2) = o;
    }
  };
  float m0 = am0;
  auto scan = [&](int c, int stage) {
    float* g = ga + stage * GST;
    const int t = lane;
    const bool valid = t < anvalid;
    const float* gp = agif + ((long)c * 64 + (valid ? t : 0)) * 8;
    float ig = valid ? gp[h] : -INFINITY;
    float lf = valid ? gp[4 + h] : 0.f;
    float b = lf;
#pragma unroll
    for (int o = 1; o < 64; o <<= 1) { float u = __shfl_up(b, o); if (lane >= o) b += u; }
    const float av = ig - b;
    float pm = av;
#pragma unroll
    for (int o = 1; o < 64; o <<= 1) { float u = __shfl_up(pm, o); if (lane >= o) pm = fmaxf(pm, u); }
    const float M = fmaxf(m0, pm);
    const float ML = __shfl(M, 63), bL = __shfl(b, 63);
    g[t] = av * LOG2E;
    g[64 + t] = M * LOG2E;
    g[128 + t] = expf(-(b + M));
    g[192 + t] = expf(m0 - M);
    g[256 + t] = expf(av - ML);
    if (lane == 0) g[320] = expf(m0 - ML);
    m0 = bL + ML;
  };
  uint4 rq0, rq1, rk0, rk1, rv0, rv1;
  const int ld_row0 = tid >> 3, ld_cc = tid & 7;
#define MLSTM_LOADC(c_) do { \
    const int rr0_ = ld_row0 < anvalid ? ld_row0 : anvalid - 1; \
    const int rr1_ = (ld_row0 + 32) < anvalid ? (ld_row0 + 32) : anvalid - 1; \
    const u16* b0_ = aZ + ((long)(c_) * 64 + rr0_) * NZ + ah * 64 + ld_cc * 8; \
    const u16* b1_ = aZ + ((long)(c_) * 64 + rr1_) * NZ + ah * 64 + ld_cc * 8; \
    rq0 = *(const uint4*)(b0_ + 2048); rk0 = *(const uint4*)(b0_ + 2304); rv0 = *(const uint4*)(b0_ + 2560); \
    rq1 = *(const uint4*)(b1_ + 2048); rk1 = *(const uint4*)(b1_ + 2304); rv1 = *(const uint4*)(b1_ + 2560); \
  } while (0)
#define MLSTM_STOREC(stage_) do { \
    char* sb_ = smem + (stage_) * STG + ld_row0 * RS + ld_cc * 16; \
    *(uint4*)(sb_) = rq0; *(uint4*)(sb_ + TB) = rk0; *(uint4*)(sb_ + 2 * TB) = rv0; \
    *(uint4*)(sb_ + 32 * RS) = rq1; *(uint4*)(sb_ + TB + 32 * RS) = rk1; *(uint4*)(sb_ + 2 * TB + 32 * RS) = rv1; \
  } while (0)
  write_ct();
  MLSTM_LOADC(0); MLSTM_STOREC(0);
  if (w == 0) scan(0, 0);
  __syncthreads();
  const unsigned ones = (l15 == 0) ? 0x3F803F80u : 0u;
  const bf16x8 onesf = mk_frag(ones, ones, ones, ones);
  for (int c = 0; c < anchunk; ++c) {
    const int stage = c & 1;
    MLSTM_LOADC(c + 1 < anchunk ? c + 1 : c);
    const char* sq = smem + stage * STG; const char* sk = sq + TB; const char* sv = sq + 2 * TB;
    const float* g = ga + stage * GST;
    const int t = 16 * w + l15;
    const float M2t = g[64 + t], emt = g[128 + t], gwt = g[192 + t];
    bf16x8 qf0 = ld_frag(sq + t * RS + quad * 16), qf1 = ld_frag(sq + t * RS + (4 + quad) * 16);
    f32x4 pt[4];
#pragma unroll
    for (int st = 0; st < 4; ++st) {
      pt[st] = (f32x4){0.f, 0.f, 0.f, 0.f};
      if (st <= w) {
        const char* kr = sk + (st * 16 + l15) * RS;
        f32x4 z = {0.f, 0.f, 0.f, 0.f};
        z = MFMA(ld_frag(kr + quad * 16), qf0, z);
        z = MFMA(ld_frag(kr + (4 + quad) * 16), qf1, z);
        float4 a2 = *(const float4*)(g + st * 16 + quad * 4);
        const float av[4] = {a2.x, a2.y, a2.z, a2.w};
#pragma unroll
        for (int j = 0; j < 4; ++j) {
          const int s = st * 16 + quad * 4 + j;
          const float dw = (s <= t) ? ex2(av[j] - M2t) : 0.f;
          pt[st][j] = z[j] * dw;
        }
      }
    }
    bf16x8 pf[2];
#pragma unroll
    for (int ks2 = 0; ks2 < 2; ++ks2)
      pf[ks2] = mk_frag(pack2(pt[2 * ks2][0], pt[2 * ks2][1]), pack2(pt[2 * ks2][2], pt[2 * ks2][3]),
                        pack2(pt[2 * ks2 + 1][0], pt[2 * ks2 + 1][1]), pack2(pt[2 * ks2 + 1][2], pt[2 * ks2 + 1][3]));
    f32x4 H[5];
    const char* vl = sv + (quad * 4 + q4) * RS + p4 * 8;
#pragma unroll
    for (int dt = 0; dt < 5; ++dt) {
      const char* cr = ct + (dt * 16 + l15) * RS;
      f32x4 z = {0.f, 0.f, 0.f, 0.f};
      z = MFMA(ld_frag(cr + quad * 16), qf0, z);
      z = MFMA(ld_frag(cr + (4 + quad) * 16), qf1, z);
      z *= gwt;
#pragma unroll
      for (int ks2 = 0; ks2 < 2; ++ks2) {
        bf16x8 vf = (dt < 4) ? tr_frag(vl + ks2 * 32 * RS + dt * 32, 16 * RS) : onesf;
        z = MFMA(vf, pf[ks2], z);
      }
      H[dt] = z;
    }
    const float den = __shfl(H[4][0], l15);
    const float sc = 1.f / fmaxf(fabsf(den), emt);
    float ss = 0.f;
#pragma unroll
    for (int dt = 0; dt < 4; ++dt)
#pragma unroll
      for (int j = 0; j < 4; ++j) { float hv = H[dt][j] * sc; H[dt][j] = hv; ss += hv * hv; }
    ss += __shfl_xor(ss, 16); ss += __shfl_xor(ss, 32);
    const float r = rsqrtf(ss * (1.f / 64.f) + EPS);
    if (t < anvalid) {
      const u16* zr = aZ + ((long)c * 64 + t) * NZ + h * 64;
      u16* mr = amix + ((long)c * 64 + t) * aldm + 512 + h * 64;
#pragma unroll
      for (int dt = 0; dt < 4; ++dt) {
        const int col = dt * 16 + quad * 4;
        uint2 ob = *(const uint2*)(zr + 2816 + col);
        uint2 gb = *(const uint2*)(zr + 3072 + col);
        float4 gm = *(const float4*)(ag_mh + col);
        float o0 = H[dt][0] * r * gm.x * bf_lo(ob.x) * bf_lo(gb.x);
        float o1 = H[dt][1] * r * gm.y * bf_hi(ob.x) * bf_hi(gb.x);
        float o2 = H[dt][2] * r * gm.z * bf_lo(ob.y) * bf_lo(gb.y);
        float o3 = H[dt][3] * r * gm.w * bf_hi(ob.y) * bf_hi(gb.y);
        uint2 o = {pack2(o0, o1), pack2(o2, o3)};
        *(uint2*)(mr + col) = o;
      }
    }
    {
      const float decay = g[320];
#pragma unroll
      for (int dt = 0; dt < 5; ++dt) Cacc[dt] *= decay;
      const char* kl = sk + (quad * 8 + q4) * RS + 16 * w * 2 + p4 * 8;
      const char* vl2 = sv + (quad * 8 + q4) * RS + p4 * 8;
#pragma unroll
      for (int ks2 = 0; ks2 < 2; ++ks2) {
        uint2 ka = tr_read(kl + ks2 * 32 * RS), kb2 = tr_read(kl + ks2 * 32 * RS + 4 * RS);
        float4 w0 = *(const float4*)(g + 256 + ks2 * 32 + quad * 8), w1 = *(const float4*)(g + 256 + ks2 * 32 + quad * 8 + 4);
        bf16x8 kw = mk_frag(pack2(bf_lo(ka.x) * w0.x, bf_hi(ka.x) * w0.y), pack2(bf_lo(ka.y) * w0.z, bf_hi(ka.y) * w0.w),
                            pack2(bf_lo(kb2.x) * w1.x, bf_hi(kb2.x) * w1.y), pack2(bf_lo(kb2.y) * w1.z, bf_hi(kb2.y) * w1.w));
#pragma unroll
        for (int dt = 0; dt < 5; ++dt) {
          bf16x8 vf = (dt < 4) ? tr_frag(vl2 + ks2 * 32 * RS + dt * 32, 4 * RS) : onesf;
          Cacc[dt] = MFMA(kw, vf, Cacc[dt]);
        }
      }
    }
    __syncthreads();
    write_ct();
    MLSTM_STOREC((c + 1) & 1);
    if (c + 1 < anchunk && w == 0) scan(c + 1, (c + 1) & 1);
    __syncthreads();
  }
#pragma unroll
  for (int dt = 0; dt < 4; ++dt)
#pragma unroll
    for (int j = 0; j < 4; ++j) aoC[(16 * w + quad * 4 + j) * 64 + dt * 16 + l15] = Cacc[dt][j];
  if (l15 == 0) {
#pragma unroll
    for (int j = 0; j < 4; ++j) aoN[16 * w + quad * 4 + j] = Cacc[4][j];
  }
  if (tid == 0) *aoM = m0;
}

DI int next_item(int* counter, int* s_item) {
  __syncthreads();
  if (threadIdx.x == 0) *s_item = atomicAdd(counter, 1);
  __syncthreads();
  return *s_item;
}

DI void phase2(const Params& p, char* smem) {
  char* ws = p.ws;
  int* s_item = (int*)(smem + LDS_BYTES - 16);
  int* counters = (int*)(ws + WS_CTL);
  const u16* Z = (const u16*)(ws + WS_Z); const u16* ZS = (const u16*)(ws + WS_ZS);
  u16* MIX = (u16*)(ws + WS_MIX); u16* MIXS = (u16*)(ws + WS_MIXS);
  while (true) {
    const int it = next_item(counters + 4, s_item);
    if (it >= 160) break;
    if (it < 128) {
      const int b = it >> 2, h = it & 3;
      mlstm_item(Z + (long)b * 2048 * NZ, 32, 64, (const float*)(ws + WS_GIF) + (long)b * 2048 * 8, h, p.sC, p.sN, 0.f, false,
                 MIX + (long)b * 2048 * 1024, 1024, p.g_mh, p.out + O_PC + (long)(b * 4 + h) * 4096, p.out + O_PN + (b * 4 + h) * 64,
                 p.out + O_PM + b * 4 + h, smem);
    } else {
      const int u = it - 128; const int b = u >> 2, h = u & 3;
      mlstm_item(ZS + (long)b * 16 * NZ, 1, 16, (const float*)(ws + WS_GIFS) + (long)b * 16 * 8, h, p.sC + (long)(b * 4 + h) * 4096,
                 p.sN + (b * 4 + h) * 64, p.sM[b * 4 + h], true, MIXS + (long)b * 16 * 1024, 1024, p.g_mh,
                 p.out + O_SC + (long)(b * 4 + h) * 4096, p.out + O_SN + (b * 4 + h) * 64, p.out + O_SM + b * 4 + h, smem);
    }
  }
  {
    const float lam = ((const float*)(ws + WS_CTL))[1];
    while (true) {
      const int it = next_item(counters + 8, s_item);
      if (it >= 32 + 2048) break;
      const u16 *aQ, *aK, *aV, *agate; u16* aout; long ldq, ldk; int nq, nkeys, tlo, thi, qpos0, h;
      if (it < 32) {
        const int b = it >> 2; h = it & 3;
        aQ = ZS + (long)b * 16 * NZ + h * 128; ldq = NZ; nq = 16;
        aK = (const u16*)(ws + WS_KS) + (long)b * SKS * 512 + h * 128; aV = (const u16*)(ws + WS_VS) + (long)b * SKS * 512 + h * 128;
        ldk = 512; nkeys = SKS; tlo = 33; thi = 33; qpos0 = 2048;
        agate = ZS + (long)b * 16 * NZ + 1536 + h * 128; aout = MIXS + (long)b * 16 * 1024 + h * 128;
      } else {
        const int u = it - 32; const int qb = 15 - (u >> 7); const int bh = u & 127; const int b = bh >> 2; h = bh & 3;
        const long tok0 = (long)b * 2048 + qb * 128;
        aQ = Z + tok0 * NZ + h * 128; ldq = NZ; nq = 128;
        aK = Z + (long)b * 2048 * NZ + 512 + h * 128; aV = Z + (long)b * 2048 * NZ + 1024 + h * 128;
        ldk = NZ; nkeys = 2048; tlo = 2 * qb + 1; thi = 2 * qb + 2; qpos0 = qb * 128;
        agate = Z + tok0 * NZ + 1536 + h * 128; aout = MIX + tok0 * 1024 + h * 128;
      }
      attn_item<2, 128, true>(aQ, ldq, nq, aK, aV, ldk, ldk, nkeys, tlo, thi, qpos0, exp2f(-2.f * (h + 1)) * LOG2E, lam, agate, NZ,
                              aout, 1024, p.g_subln, smem);
    }
  }
  while (true) {
    const int it = next_item(counters + 12, s_item);
    if (it >= 2048 + 32) break;
    const u16 *aQ, *aK, *agate; u16* aout; int nq;
    if (it < 2048) {
      const int tb = it >> 2, h = it & 3; const int b = tb >> 4;
      const long tok0 = (long)tb * 128;
      aQ = Z + tok0 * NZ + 3328 + h * 64; nq = 128;
      aK = (const u16*)(ws + WS_MKV) + (long)b * 256 * 512 + h * 64;
      agate = Z + tok0 * NZ + 3584 + h * 64; aout = MIX + tok0 * 1024 + 768 + h * 64;
    } else {
      const int u = it - 2048; const int b = u >> 2, h = u & 3;
      aQ = ZS + (long)b * 16 * NZ + 3328 + h * 64; nq = 16;
      aK = (const u16*)(ws + WS_MKVS) + (long)b * 256 * 512 + h * 64;
      agate = ZS + (long)b * 16 * NZ + 3584 + h * 64; aout = MIXS + (long)b * 16 * 1024 + 768 + h * 64;
    }
    attn_item<1, 64, false>(aQ, NZ, nq, aK, aK + 256, 512, 512, 256, 4, 4, 0, 0.f, 0.f, agate, NZ, aout, 1024, p.g_subln, smem);
  }
}

__global__ void __launch_bounds__(256) fwd_megakernel(Params p, int phase_lo, int phase_hi, int coop) {
  extern __shared__ __attribute__((aligned(16))) char smem[];
  cg::grid_group grid = cg::this_grid();
  if (phase_lo <= 0 && phase_hi > 0) phase0(p, smem);
  if (coop) { __threadfence(); grid.sync(); }
  if (phase_lo <= 1 && phase_hi > 1) phase1(p, smem);
  if (coop) { __threadfence(); grid.sync(); }
  if (phase_lo <= 2 && phase_hi > 2) phase2(p, smem);
  if (coop) { __threadfence(); grid.sync(); }
  if (phase_lo <= 3 && phase_hi > 3) phase3(p, smem);
}

extern "C" void kernel_launch(void* const* d_in, const int* in_sizes, int n_in, void* d_out, int out_size,
                              void* d_ws, size_t ws_size, hipStream_t stream) {
  static int grid_blocks = 0;
  if (!grid_blocks) {
    int dev = 0, cus = 0, per_cu = 0;
    (void)hipGetDevice(&dev);
    (void)hipDeviceGetAttribute(&cus, hipDeviceAttributeMultiprocessorCount, dev);
    (void)hipFuncSetAttribute((const void*)fwd_megakernel, hipFuncAttributeMaxDynamicSharedMemorySize, LDS_BYTES);
    (void)hipOccupancyMaxActiveBlocksPerMultiprocessor(&per_cu, fwd_megakernel, 256, LDS_BYTES);
    if (per_cu < 1) per_cu = 1;
    if (per_cu > 1) per_cu = 1;
    grid_blocks = cus * per_cu;
    if (ws_size < WS_END) fprintf(stderr, "workspace too small: %zu < %zu\n", ws_size, (size_t)WS_END);
  }
  Params p{};
  const float** pp = (const float**)&p;
  for (int i = 0; i < 28; ++i) pp[i] = (const float*)d_in[i];
  p.out = (float*)d_out; p.ws = (char*)d_ws;
  int lo = 0, hi = 4, coop = 1;
  void* args[] = {&p, &lo, &hi, &coop};
  hipError_t e = hipLaunchCooperativeKernel((void*)fwd_megakernel, dim3(grid_blocks), dim3(256), args, LDS_BYTES, stream);
  if (e != hipSuccess) fprintf(stderr, "cooperative launch failed: %s (grid %d)\n", hipGetErrorString(e), grid_blocks);
}
```

```cpp
#include <hip/hip_runtime.h>
#include <hip/hip_cooperative_groups.h>
#include <cstdio>
namespace cg = cooperative_groups;

typedef unsigned short u16;
typedef short bf16x8 __attribute__((ext_vector_type(8)));
typedef short s16x4 __attribute__((ext_vector_type(4)));
typedef float f32x4 __attribute__((ext_vector_type(4)));
typedef float f32x2 __attribute__((ext_vector_type(2)));
typedef __bf16 bf16x2_t __attribute__((ext_vector_type(2)));
#define DI __device__ __forceinline__
#define MFMA(a, b, c) __builtin_amdgcn_mfma_f32_16x16x32_bf16((a), (b), (c), 0, 0, 0)

constexpr int DM = 1024;
constexpr int TP = 65536;
constexpr int TS = 128;
constexpr int TMEM = 8192;
constexpr int NZ = 3840;
constexpr int NIN = 3848;
constexpr int SKS = 2064;
constexpr float EPS = 1e-6f;
constexpr float LOG2E = 1.4426950408889634f;
constexpr float QSCALE = 0.125f * LOG2E;

constexpr size_t WS_CTL = 0;
constexpr size_t WS_WTIN = 4096;
constexpr size_t WS_WTOUT = WS_WTIN + (size_t)NZ * 1024 * 2;
constexpr size_t WS_WTM = WS_WTOUT + (size_t)1024 * 1024 * 2;
constexpr size_t WS_XB = WS_WTM + (size_t)512 * 1024 * 2;
constexpr size_t WS_XSB = WS_XB + (size_t)TP * 1024 * 2;
constexpr size_t WS_MB = WS_XSB + (size_t)TS * 1024 * 2;
constexpr size_t WS_RSTD = WS_MB + (size_t)TMEM * 1024 * 2;
constexpr size_t WS_RSTDS = WS_RSTD + (size_t)TP * 4;
constexpr size_t WS_RSTDM = WS_RSTDS + (size_t)TS * 4;
constexpr size_t WS_GIF = WS_RSTDM + (size_t)TMEM * 4;
constexpr size_t WS_GIFS = WS_GIF + (size_t)TP * 8 * 4;
constexpr size_t WS_Z = WS_GIFS + (size_t)TS * 8 * 4;
constexpr size_t WS_ZS = WS_Z + (size_t)TP * NZ * 2;
constexpr size_t WS_MIX = WS_ZS + (size_t)TS * NZ * 2;
constexpr size_t WS_MIXS = WS_MIX + (size_t)TP * 1024 * 2;
constexpr size_t WS_KS = WS_MIXS + (size_t)TS * 1024 * 2;
constexpr size_t WS_VS = WS_KS + (size_t)8 * SKS * 512 * 2;
constexpr size_t WS_MKV = WS_VS + (size_t)8 * SKS * 512 * 2;
constexpr size_t WS_MKVS = WS_MKV + (size_t)TMEM * 512 * 2;
constexpr size_t WS_END = WS_MKVS + (size_t)2048 * 512 * 2;

constexpr long O_Y = 0;
constexpr long O_YS = O_Y + 67108864L;
constexpr long O_PK = O_YS + 131072L;
constexpr long O_PV = O_PK + 33554432L;
constexpr long O_PC = O_PV + 33554432L;
constexpr long O_PN = O_PC + 524288L;
constexpr long O_PM = O_PN + 8192L;
constexpr long O_PMK = O_PM + 128L;
constexpr long O_PMV = O_PMK + 2097152L;
constexpr long O_SK = O_PMV + 2097152L;
constexpr long O_SV = O_SK + 65536L;
constexpr long O_SC = O_SV + 65536L;
constexpr long O_SN = O_SC + 131072L;
constexpr long O_SM = O_SN + 2048L;

constexpr int LDS_BYTES = 131072 + 64;
constexpr int NT = 512;
constexpr int NWV = 8;
#ifndef PROBE_DUP
#define PROBE_DUP 0
#endif

struct Params {
  const float* x; const float* xs; const float* ck; const float* cv; const float* sC; const float* sN; const float* sM;
  const float* cmk; const float* cmv; const float* mem; const float* g_norm; const float* w_in; const float* w_out;
  const float* g_qa; const float* g_ka; const float* lq1; const float* lk1; const float* lq2; const float* lk2;
  const float* g_subln; const float* b_i; const float* b_f; const float* g_mh; const float* g_qm; const float* g_km;
  const float* g_mem; const float* w_mk; const float* w_mv;
  float* out; char* ws;
};

DI unsigned pack2(float a, float b) { f32x2 v = {a, b}; return __builtin_bit_cast(unsigned, __builtin_convertvector(v, bf16x2_t)); }
DI float bf_lo(unsigned u) { return __uint_as_float(u << 16); }
DI float bf_hi(unsigned u) { return __uint_as_float(u & 0xffff0000u); }
DI float ex2(float x) { return __builtin_amdgcn_exp2f(x); }
DI bf16x8 ld_frag(const char* p) { return __builtin_bit_cast(bf16x8, *(const uint4*)p); }
DI bf16x8 mk_frag(unsigned a, unsigned b, unsigned c, unsigned d) { uint4 v = {a, b, c, d}; return __builtin_bit_cast(bf16x8, v); }
DI uint2 tr_read(const char* p) {
  s16x4 r = __builtin_amdgcn_ds_read_tr16_b64_v4i16((__attribute__((address_space(3))) s16x4*)(p));
  return __builtin_bit_cast(uint2, r);
}
DI bf16x8 tr_frag(const char* p, int off2) { uint2 a = tr_read(p), b = tr_read(p + off2); return mk_frag(a.x, a.y, b.x, b.y); }
DI float wave_sum(float v) {
#pragma unroll
  for (int o = 32; o > 0; o >>= 1) v += __shfl_xor(v, o);
  return v;
}
DI float silu_f(float x) { return x / (1.f + __expf(-x)); }
DI float sigm_f(float x) { return 1.f / (1.f + __expf(-x)); }

DI void phase0(const Params& p, char* smem) {
  const int tid = threadIdx.x, lane = tid & 63, wave = tid >> 6;
  char* ws = p.ws;
  if (blockIdx.x == 0 && wave == 0) {
    float a = wave_sum(p.lq1[lane] * p.lk1[lane]);
    float b = wave_sum(p.lq2[lane] * p.lk2[lane]);
    if (lane == 0) {
      ((int*)(ws + WS_CTL))[4] = 0; ((int*)(ws + WS_CTL))[8] = 0; ((int*)(ws + WS_CTL))[12] = 0;
      ((int*)(ws + WS_CTL))[20] = 0; ((int*)(ws + WS_CTL))[24] = 0; ((int*)(ws + WS_CTL))[28] = 0;
      ((float*)(ws + WS_CTL))[1] = expf(a) - expf(b) + 0.2f;
    }
  }
  float* WG = (float*)smem;
  for (int k = tid; k < 1024; k += NT) {
    float g = p.g_norm[k];
    float4 a = *(const float4*)(p.w_in + (long)k * NIN + 3072);
    float4 b = *(const float4*)(p.w_in + (long)k * NIN + 3076);
    float4 a2 = {a.x * g, a.y * g, a.z * g, a.w * g}, b2 = {b.x * g, b.y * g, b.z * g, b.w * g};
    *(float4*)(WG + k * 8) = a2; *(float4*)(WG + k * 8 + 4) = b2;
  }
  __syncthreads();
  {
    const int gw = blockIdx.x * NWV + wave, nw = gridDim.x * NWV;
    for (int r = gw; r < TP + TS + TMEM; r += nw) {
      const float* src; u16* dst; float* rs; float* gif;
      if (r < TP) { src = p.x + (long)r * 1024; dst = (u16*)(ws + WS_XB) + (long)r * 1024; rs = (float*)(ws + WS_RSTD) + r; gif = (float*)(ws + WS_GIF) + (long)r * 8; }
      else if (r < TP + TS) { int q = r - TP; src = p.xs + (long)q * 1024; dst = (u16*)(ws + WS_XSB) + (long)q * 1024; rs = (float*)(ws + WS_RSTDS) + q; gif = (float*)(ws + WS_GIFS) + (long)q * 8; }
      else { int q = r - TP - TS; src = p.mem + (long)q * 1024; dst = (u16*)(ws + WS_MB) + (long)q * 1024; rs = (float*)(ws + WS_RSTDM) + q; gif = nullptr; }
      float4 v[4];
#pragma unroll
      for (int i = 0; i < 4; ++i) v[i] = *(const float4*)(src + i * 256 + lane * 4);
      float ss = 0.f;
#pragma unroll
      for (int i = 0; i < 4; ++i) ss += v[i].x * v[i].x + v[i].y * v[i].y + v[i].z * v[i].z + v[i].w * v[i].w;
      ss = wave_sum(ss);
      const float rstd = rsqrtf(ss * (1.f / 1024.f) + EPS);
#pragma unroll
      for (int i = 0; i < 4; ++i) {
        uint2 o = {pack2(v[i].x, v[i].y), pack2(v[i].z, v[i].w)};
        *(uint2*)(dst + i * 256 + lane * 4) = o;
      }
      if (lane == 0) *rs = rstd;
      if (gif) {
        float g[8];
#pragma unroll
        for (int j = 0; j < 8; ++j) g[j] = 0.f;
#pragma unroll
        for (int i = 0; i < 4; ++i) {
          const float xv[4] = {v[i].x, v[i].y, v[i].z, v[i].w};
#pragma unroll
          for (int e = 0; e < 4; ++e) {
            const float* wr = WG + (i * 256 + lane * 4 + e) * 8;
            float4 wa = *(const float4*)wr, wb = *(const float4*)(wr + 4);
            g[0] += xv[e] * wa.x; g[1] += xv[e] * wa.y; g[2] += xv[e] * wa.z; g[3] += xv[e] * wa.w;
            g[4] += xv[e] * wb.x; g[5] += xv[e] * wb.y; g[6] += xv[e] * wb.z; g[7] += xv[e] * wb.w;
          }
        }
#pragma unroll
        for (int j = 0; j < 8; ++j) g[j] = wave_sum(g[j]);
        if (lane == 0) {
          float o[8];
#pragma unroll
          for (int j = 0; j < 4; ++j) o[j] = g[j] * rstd + p.b_i[j];
#pragma unroll
          for (int j = 0; j < 4; ++j) {
            float xx = g[4 + j] * rstd + p.b_f[j];
            o[4 + j] = fminf(xx, 0.f) - log1pf(expf(-fabsf(xx)));
          }
          float4 oa = {o[0], o[1], o[2], o[3]}, ob = {o[4], o[5], o[6], o[7]};
          *(float4*)gif = oa; *(float4*)(gif + 4) = ob;
        }
      }
    }
  }
  const long gtid = (long)blockIdx.x * NT + tid, nth = (long)gridDim.x * NT;
  {
    u16* wt = (u16*)(ws + WS_WTIN);
    for (long idx = gtid; idx < (long)NZ * 128; idx += nth) {
      int n = (int)(idx % NZ), kc = (int)(idx / NZ);
      int on = n < 3072 ? n : n + 8;
      float v[8];
#pragma unroll
      for (int e = 0; e < 8; ++e) v[e] = p.w_in[(long)(kc * 8 + e) * NIN + on] * p.g_norm[kc * 8 + e];
      uint4 o = {pack2(v[0], v[1]), pack2(v[2], v[3]), pack2(v[4], v[5]), pack2(v[6], v[7])};
      *(uint4*)(wt + (long)n * 1024 + kc * 8) = o;
    }
    u16* wo = (u16*)(ws + WS_WTOUT);
    for (long idx = gtid; idx < 1024L * 128; idx += nth) {
      int n = (int)(idx % 1024), kc = (int)(idx / 1024);
      float v[8];
#pragma unroll
      for (int e = 0; e < 8; ++e) v[e] = p.w_out[(long)(kc * 8 + e) * 1024 + n];
      uint4 o = {pack2(v[0], v[1]), pack2(v[2], v[3]), pack2(v[4], v[5]), pack2(v[6], v[7])};
      *(uint4*)(wo + (long)n * 1024 + kc * 8) = o;
    }
    u16* wm = (u16*)(ws + WS_WTM);
    for (long idx = gtid; idx < 512L * 128; idx += nth) {
      int n = (int)(idx % 512), kc = (int)(idx / 512);
      const float* src = n < 256 ? p.w_mk + n : p.w_mv + (n - 256);
      float v[8];
#pragma unroll
      for (int e = 0; e < 8; ++e) v[e] = src[(long)(kc * 8 + e) * 256] * p.g_mem[kc * 8 + e];
      uint4 o = {pack2(v[0], v[1]), pack2(v[2], v[3]), pack2(v[4], v[5]), pack2(v[6], v[7])};
      *(uint4*)(wm + (long)n * 1024 + kc * 8) = o;
    }
  }
  {
    u16* ks = (u16*)(ws + WS_KS); u16* vs = (u16*)(ws + WS_VS);
    for (long idx = gtid; idx < 2L * 8 * 2048 * 64; idx += nth) {
      long id = idx; const float* srcb = p.ck; u16* dstb = ks;
      if (id >= 8L * 2048 * 64) { id -= 8L * 2048 * 64; srcb = p.cv; dstb = vs; }
      int c = (int)(id & 63); long row = id >> 6; int b = (int)(row >> 11); int rr = (int)(row & 2047);
      const float* s = srcb + row * 512 + c * 8;
      float4 a = *(const float4*)s, bb = *(const float4*)(s + 4);
      uint4 o = {pack2(a.x, a.y), pack2(a.z, a.w), pack2(bb.x, bb.y), pack2(bb.z, bb.w)};
      *(uint4*)(dstb + ((long)b * SKS + rr) * 512 + c * 8) = o;
    }
    u16* mk = (u16*)(ws + WS_MKVS);
    for (long idx = gtid; idx < 2L * 2048 * 32; idx += nth) {
      long id = idx; const float* srcb = p.cmk; int coff = 0;
      if (id >= 2048L * 32) { id -= 2048L * 32; srcb = p.cmv; coff = 256; }
      int c = (int)(id & 31); long row = id >> 5;
      const float* s = srcb + row * 256 + c * 8;
      float4 a = *(const float4*)s, bb = *(const float4*)(s + 4);
      uint4 o = {pack2(a.x, a.y), pack2(a.z, a.w), pack2(bb.x, bb.y), pack2(bb.z, bb.w)};
      *(uint4*)(mk + row * 512 + coff + c * 8) = o;
    }
  }
}

struct EpiCfg {
  const float* rs; const float* gain; float post; int act;
  float* o32; long ld32; int c32;
  u16* ob; long ldb; int cb;
  u16* ob2; int c2;
  const float* resid;
};

DI void gemm_mainloop(const u16* __restrict__ A, int M, const u16* __restrict__ W, int m0, int n0, char* smem, f32x4 (&acc)[8][4]) {
  int tid = threadIdx.x; asm volatile("" : "+v"(tid));
  const int lane = tid & 63, wave = tid >> 6;
  const int l15 = lane & 15, quad = lane >> 4, l7 = lane & 7;
  const int wt = wave & 3, wf_ = wave >> 2;
  const int c8 = tid & 7, r0 = tid >> 3;
#pragma unroll
  for (int a = 0; a < 8; ++a)
#pragma unroll
    for (int b = 0; b < 4; ++b) acc[a][b] = (f32x4){0.f, 0.f, 0.f, 0.f};
  uint4 ra[4], rw[4];
  const int st_off = r0 * 128 + ((c8 ^ (r0 & 7)) * 16);
  auto loadk = [&](int kt) {
#pragma unroll
    for (int i = 0; i < 4; ++i) {
      int row = m0 + r0 + 64 * i; row = row < M ? row : M - 1;
      ra[i] = *(const uint4*)(A + (long)row * 1024 + kt * 64 + c8 * 8);
    }
#pragma unroll
    for (int i = 0; i < 4; ++i) rw[i] = *(const uint4*)(W + (long)(n0 + r0 + 64 * i) * 1024 + kt * 64 + c8 * 8);
  };
  auto storek = [&](int stage) {
    char* sa = smem + stage * 65536; char* sw = sa + 32768;
#pragma unroll
    for (int i = 0; i < 4; ++i) *(uint4*)(sa + st_off + i * 8192) = ra[i];
#pragma unroll
    for (int i = 0; i < 4; ++i) *(uint4*)(sw + st_off + i * 8192) = rw[i];
  };
  loadk(0); storek(0); __syncthreads();
  for (int kt = 0; kt < 16; ++kt) {
    loadk(kt + 1 < 16 ? kt + 1 : kt);
    const char* sa = smem + (kt & 1) * 65536; const char* sw = sa + 32768;
#pragma unroll
    for (int ks = 0; ks < 2; ++ks) {
      const int sw_off = ((ks * 4 + quad) ^ l7) * 16;
      bf16x8 wfr[8];
#pragma unroll
      for (int fi = 0; fi < 8; ++fi) wfr[fi] = ld_frag(sw + (wf_ * 128 + fi * 16 + l15) * 128 + sw_off);
#pragma unroll
      for (int ti = 0; ti < 4; ++ti) {
        const bf16x8 tf = ld_frag(sa + (wt * 64 + ti * 16 + l15) * 128 + sw_off);
#pragma unroll
        for (int fi = 0; fi < 8; ++fi) acc[fi][ti] = MFMA(wfr[fi], tf, acc[fi][ti]);
      }
    }
    storek((kt + 1) & 1);
    __syncthreads();
  }
}

template <int H>
DI void gemm_epilogue(const EpiCfg& e, int M, int m0, f32x4 (&acc)[8][4]) {
  int tid = threadIdx.x; asm volatile("" : "+v"(tid));
  const int lane = tid & 63, wave = tid >> 6;
  const int l15 = lane & 15, quad = lane >> 4;
  const int wt = wave & 3;
  float gn[4][4];
  if (e.gain) {
#pragma unroll
    for (int fi = 0; fi < 4; ++fi) { float4 g = *(const float4*)(e.gain + fi * 16 + quad * 4); gn[fi][0] = g.x; gn[fi][1] = g.y; gn[fi][2] = g.z; gn[fi][3] = g.w; }
  }
#pragma unroll
  for (int ti = 0; ti < 4; ++ti) {
    const int tok = m0 + wt * 64 + ti * 16 + l15;
    const bool valid = tok < M;
    const int tokc = valid ? tok : M - 1;
    float v[4][4];
    const float rs = e.rs ? e.rs[tokc] : 1.f;
#pragma unroll
    for (int fi = 0; fi < 4; ++fi)
#pragma unroll
      for (int j = 0; j < 4; ++j) v[fi][j] = acc[H * 4 + fi][ti][j] * rs;
    if (e.gain) {
      float ss = 0.f;
#pragma unroll
      for (int fi = 0; fi < 4; ++fi)
#pragma unroll
        for (int j = 0; j < 4; ++j) ss += v[fi][j] * v[fi][j];
      ss += __shfl_xor(ss, 16); ss += __shfl_xor(ss, 32);
      const float r = rsqrtf(ss * (1.f / 64.f) + EPS);
#pragma unroll
      for (int fi = 0; fi < 4; ++fi)
#pragma unroll
        for (int j = 0; j < 4; ++j) v[fi][j] *= r * gn[fi][j];
    }
    if (e.resid && valid) {
#pragma unroll
      for (int fi = 0; fi < 4; ++fi) {
        float4 x4 = *(const float4*)(e.resid + (long)tok * 1024 + e.c32 + fi * 16 + quad * 4);
        v[fi][0] += x4.x; v[fi][1] += x4.y; v[fi][2] += x4.z; v[fi][3] += x4.w;
      }
    }
    if (e.o32 && valid) {
#pragma unroll
      for (int fi = 0; fi < 4; ++fi) {
        float4 o = {v[fi][0], v[fi][1], v[fi][2], v[fi][3]};
        *(float4*)(e.o32 + (long)tok * e.ld32 + e.c32 + fi * 16 + quad * 4) = o;
      }
    }
    if (e.ob) {
#pragma unroll
      for (int fi = 0; fi < 4; ++fi)
#pragma unroll
        for (int j = 0; j < 4; ++j) {
          float t = v[fi][j] * e.post;
          if (e.act == 1) t = silu_f(t); else if (e.act == 2) t = sigm_f(t);
          v[fi][j] = t;
        }
      if (valid) {
#pragma unroll
        for (int fi = 0; fi < 4; ++fi) {
          uint2 o = {pack2(v[fi][0], v[fi][1]), pack2(v[fi][2], v[fi][3])};
          *(uint2*)(e.ob + (long)tok * e.ldb + e.cb + fi * 16 + quad * 4) = o;
          if (e.ob2) {
            long row2 = (long)(tok >> 4) * SKS + 2048 + (tok & 15);
            *(uint2*)(e.ob2 + row2 * 512 + e.c2 + fi * 16 + quad * 4) = o;
          }
        }
      }
    }
  }
}

DI EpiCfg epi_inproj(const Params& p, int gidx, bool sample) {
  char* ws = p.ws;
  EpiCfg e{};
  e.rs = (const float*)(ws + (sample ? WS_RSTDS : WS_RSTD));
  e.post = 1.f; e.act = 0;
  e.ob = (u16*)(ws + (sample ? WS_ZS : WS_Z)); e.ldb = NZ; e.cb = gidx * 64;
  if (gidx < 8) { e.gain = p.g_qa; e.post = QSCALE; }
  else if (gidx < 16) {
    e.gain = p.g_ka; e.o32 = p.out + (sample ? O_SK : O_PK); e.ld32 = 512; e.c32 = (gidx - 8) * 64;
    if (sample) { e.ob2 = (u16*)(ws + WS_KS); e.c2 = (gidx - 8) * 64; }
  } else if (gidx < 24) {
    e.o32 = p.out + (sample ? O_SV : O_PV); e.ld32 = 512; e.c32 = (gidx - 16) * 64;
    if (sample) { e.ob2 = (u16*)(ws + WS_VS); e.c2 = (gidx - 16) * 64; }
  } else if (gidx < 32) { e.act = 1; }
  else if (gidx < 36) { }
  else if (gidx < 40) { e.post = 0.125f; }
  else if (gidx < 44) { }
  else if (gidx < 48) { e.act = 2; }
  else if (gidx < 52) { e.act = 1; }
  else if (gidx < 56) { e.gain = p.g_qm; e.post = QSCALE; }
  else { e.act = 1; }
  return e;
}

DI void phase1(const Params& p, char* smem) {
  char* ws = p.ws;
  const int wf_ = threadIdx.x >> 8;
  constexpr int T_MAIN = 256 * 15, T_MEM = 32 * 2, T_S = 15;
  for (int t = blockIdx.x; t < T_MAIN + T_MEM + T_S; t += gridDim.x) {
    const u16* A; const u16* W; int M, mt, nt, kind;
    if (t < T_MAIN) { kind = 0; mt = t / 15; nt = t % 15; A = (const u16*)(ws + WS_XB); W = (const u16*)(ws + WS_WTIN); M = TP; }
    else if (t < T_MAIN + T_MEM) { kind = 1; const int u = t - T_MAIN; mt = u / 2; nt = u % 2; A = (const u16*)(ws + WS_MB); W = (const u16*)(ws + WS_WTM); M = TMEM; }
    else { kind = 2; mt = 0; nt = t - T_MAIN - T_MEM; A = (const u16*)(ws + WS_XSB); W = (const u16*)(ws + WS_WTIN); M = TS; }
    f32x4 acc[8][4];
    gemm_mainloop(A, M, W, mt * 256, nt * 256, smem, acc);
    EpiCfg e0, e1;
    if (kind == 1) {
      EpiCfg e{};
      e.rs = (const float*)(ws + WS_RSTDM); e.post = 1.f;
      e.gain = nt == 0 ? p.g_km : nullptr;
      e.o32 = p.out + (nt == 0 ? O_PMK : O_PMV); e.ld32 = 256;
      e.ob = (u16*)(ws + WS_MKV); e.ldb = 512;
      e.c32 = (wf_ * 2) * 64; e.cb = (nt * 4 + wf_ * 2) * 64;
      e0 = e; e.c32 += 64; e.cb += 64; e1 = e;
    } else {
      e0 = epi_inproj(p, nt * 4 + wf_ * 2, kind == 2);
      e1 = epi_inproj(p, nt * 4 + wf_ * 2 + 1, kind == 2);
    }
    gemm_epilogue<0>(e0, M, mt * 256, acc);
    gemm_epilogue<1>(e1, M, mt * 256, acc);
  }
}

DI void phase3(const Params& p, char* smem) {
  char* ws = p.ws;
  const int wf_ = threadIdx.x >> 8;
  constexpr int T_MAIN = 256 * 4, T_S = 4;
  for (int t = blockIdx.x; t < T_MAIN + T_S; t += gridDim.x) {
    const bool smp = t >= T_MAIN;
    const int mt = smp ? 0 : t / 4, nt = smp ? t - T_MAIN : t % 4;
    const int M = smp ? TS : TP;
    f32x4 acc[8][4];
    gemm_mainloop((const u16*)(ws + (smp ? WS_MIXS : WS_MIX)), M, (const u16*)(ws + WS_WTOUT), mt * 256, nt * 256, smem, acc);
    EpiCfg e{};
    e.post = 1.f; e.ld32 = 1024;
    e.resid = smp ? p.xs : p.x; e.o32 = p.out + (smp ? O_YS : O_Y); e.c32 = nt * 256 + wf_ * 128;
    gemm_epilogue<0>(e, M, mt * 256, acc);
    e.c32 += 64;
    gemm_epilogue<1>(e, M, mt * 256, acc);
  }
}

struct AttnArgs {
  const u16* Q; long ldq; int nq;
  const u16* K; const u16* V; long ldk; long ldv; int nkeys;
  int ntile_lo, ntile_hi;
  int qpos0; float slope2; float lam;
  const u16* gate; long ldg;
  u16* out; long ldo;
  const float* gsub;
};

struct AttnLocal {
  const u16* Q; long ldq; int nq;
  const u16* K; const u16* V; long ldk; long ldv; int nkeys;
  int ntile_lo, ntile_hi;
  int qpos0; float slope2; float lam;
  const u16* gate; long ldg;
  u16* out; long ldo;
  const float* gsub;
};
template <int NMAP, int DV, bool ALIBI>
DI void attn_item(const u16* aQ, long aldq, int anq, const u16* aK, const u16* aV, long aldk, long aldv, int ankeys,
                  int antile_lo, int antile_hi, int aqpos0, float aslope2, float alam, const u16* agate, long aldg,
                  u16* aout, long aldo, const float* agsub, char* smem) {
  int tid = threadIdx.x; asm volatile("" : "+v"(tid));
  const int lane = tid & 63, w = tid >> 6;
  const int l15 = lane & 15, quad = lane >> 4, l7 = lane & 7;
  constexpr int KB = NMAP * 8192;
  constexpr int VSTR = DV * 2 + 32;
  constexpr int VB = 64 * VSTR;
  constexpr int STG = KB + VB;
  constexpr int NKC = NMAP;
  constexpr int NVC = DV / 64;
  constexpr int NDT = DV / 16;
  constexpr int VCR = DV / 8;

  bf16x8 qf[NMAP][2];
  {
    int row = w * 16 + l15; row = row < anq ? row : anq - 1;
#pragma unroll
    for (int m = 0; m < NMAP; ++m)
#pragma unroll
      for (int ks = 0; ks < 2; ++ks)
        qf[m][ks] = __builtin_bit_cast(bf16x8, *(const uint4*)(aQ + (long)row * aldq + m * 64 + ks * 32 + quad * 8));
  }
  f32x4 O[NMAP][NDT];
  float mrun[NMAP], lrun[NMAP];
#pragma unroll
  for (int m = 0; m < NMAP; ++m) {
    mrun[m] = -INFINITY; lrun[m] = 0.f;
#pragma unroll
    for (int dt = 0; dt < NDT; ++dt) O[m][dt] = (f32x4){0.f, 0.f, 0.f, 0.f};
  }
  const int ntile = antile_hi;
  const int myt = (w < 4) ? antile_lo : antile_hi;
  uint4 rk[NKC], rv[NVC];
  auto loadt = [&](int t) {
#pragma unroll
    for (int i = 0; i < NKC; ++i) {
      int id = tid + NT * i; int key = id / (NMAP * 8), cc = id % (NMAP * 8);
      int kr = t * 64 + key; kr = kr < ankeys ? kr : ankeys - 1;
      rk[i] = *(const uint4*)(aK + (long)kr * aldk + cc * 8);
    }
#pragma unroll
    for (int i = 0; i < NVC; ++i) {
      int id = tid + NT * i; int key = id / VCR, c = id % VCR;
      int kr = t * 64 + key; kr = kr < ankeys ? kr : ankeys - 1;
      rv[i] = *(const uint4*)(aV + (long)kr * aldv + c * 8);
    }
  };
  auto storet = [&](int stage) {
    char* kb = smem + stage * STG; char* vb = kb + KB;
#pragma unroll
    for (int i = 0; i < NKC; ++i) {
      int id = tid + NT * i; int key = id / (NMAP * 8), cc = id % (NMAP * 8);
      int m = cc >> 3, c = cc & 7;
      *(uint4*)(kb + m * 8192 + key * 128 + ((c ^ (key & 7)) * 16)) = rk[i];
    }
#pragma unroll
    for (int i = 0; i < NVC; ++i) {
      int id = tid + NT * i; int key = id / VCR, c = id % VCR;
      *(uint4*)(vb + key * VSTR + c * 16) = rv[i];
    }
  };
  const int q4 = l15 >> 2, p4 = l15 & 3;
  loadt(0); storet(0); __syncthreads();
  for (int t = 0; t < ntile; ++t) {
    loadt(t + 1 < ntile ? t + 1 : t);
    {
      const char* kb = smem + (t & 1) * STG; const char* vb = kb + KB;
      unsigned pf[NMAP][2][4];
      const bool partial = ((t + 1) * 64 > ankeys) || (t >= myt);
      const int klim = (t >= myt) ? 0 : ankeys;
#pragma unroll
      for (int m = 0; m < NMAP; ++m) {
        f32x4 s[4];
#pragma unroll
        for (int kt = 0; kt < 4; ++kt) {
          const char* kr = kb + m * 8192 + (kt * 16 + l15) * 128;
          f32x4 z = {0.f, 0.f, 0.f, 0.f};
          z = MFMA(ld_frag(kr + ((quad ^ l7) * 16)), qf[m][0], z);
          s[kt] = MFMA(ld_frag(kr + (((4 + quad) ^ l7) * 16)), qf[m][1], z);
        }
        if (ALIBI) {
          const float dq = (float)(aqpos0 + w * 16 + l15 - t * 64 - quad * 4);
#pragma unroll
          for (int kt = 0; kt < 4; ++kt)
#pragma unroll
            for (int j = 0; j < 4; ++j) s[kt][j] = fmaf(-aslope2, fabsf(dq - (float)(kt * 16 + j)), s[kt][j]);
        }
        if (partial) {
#pragma unroll
          for (int kt = 0; kt < 4; ++kt)
#pragma unroll
            for (int j = 0; j < 4; ++j) {
              const bool bad = (t * 64 + kt * 16 + quad * 4 + j) >= klim;
              s[kt][j] = bad ? -INFINITY : s[kt][j];
            }
        }
        float mx = -INFINITY;
#pragma unroll
        for (int kt = 0; kt < 4; ++kt)
#pragma unroll
          for (int j = 0; j < 4; ++j) mx = fmaxf(mx, s[kt][j]);
        mx = fmaxf(mx, __shfl_xor(mx, 16)); mx = fmaxf(mx, __shfl_xor(mx, 32));
        const float mnew = fmaxf(mrun[m], mx);
        const float alpha = ex2(mrun[m] - mnew);
        mrun[m] = mnew;
        float psum = 0.f;
#pragma unroll
        for (int kt = 0; kt < 4; ++kt)
#pragma unroll
          for (int j = 0; j < 4; ++j) { float pv = ex2(s[kt][j] - mnew); psum += pv; s[kt][j] = pv; }
        lrun[m] = lrun[m] * alpha + psum;
#pragma unroll
        for (int dt = 0; dt < NDT; ++dt) O[m][dt] *= alpha;
#pragma unroll
        for (int ks2 = 0; ks2 < 2; ++ks2) {
          pf[m][ks2][0] = pack2(s[2 * ks2][0], s[2 * ks2][1]);
          pf[m][ks2][1] = pack2(s[2 * ks2][2], s[2 * ks2][3]);
          pf[m][ks2][2] = pack2(s[2 * ks2 + 1][0], s[2 * ks2 + 1][1]);
          pf[m][ks2][3] = pack2(s[2 * ks2 + 1][2], s[2 * ks2 + 1][3]);
        }
      }
      const char* vl = vb + (quad * 4 + q4) * VSTR + p4 * 8;
#pragma unroll
      for (int ks2 = 0; ks2 < 2; ++ks2)
#pragma unroll
        for (int dt = 0; dt < NDT; ++dt) {
          bf16x8 vf = tr_frag(vl + ks2 * 32 * VSTR + dt * 32, 16 * VSTR);
#pragma unroll
          for (int m = 0; m < NMAP; ++m)
            O[m][dt] = MFMA(vf, mk_frag(pf[m][ks2][0], pf[m][ks2][1], pf[m][ks2][2], pf[m][ks2][3]), O[m][dt]);
        }
    }
    storet((t + 1) & 1);
    __syncthreads();
  }
  {
    float l0 = lrun[0]; l0 += __shfl_xor(l0, 16); l0 += __shfl_xor(l0, 32);
    const float inv0 = 1.f / l0;
    float inv1 = 0.f;
    if (NMAP == 2) { float l1 = lrun[NMAP - 1]; l1 += __shfl_xor(l1, 16); l1 += __shfl_xor(l1, 32); inv1 = alam / l1; }
    float ss = 0.f;
#pragma unroll
    for (int dt = 0; dt < NDT; ++dt)
#pragma unroll
      for (int j = 0; j < 4; ++j) {
        float o = O[0][dt][j] * inv0;
        if (NMAP == 2) o -= O[NMAP - 1][dt][j] * inv1;
        O[0][dt][j] = o; ss += o * o;
      }
    float r = 1.f;
    if (NMAP == 2) {
      ss += __shfl_xor(ss, 16); ss += __shfl_xor(ss, 32);
      r = rsqrtf(ss * (1.f / DV) + EPS) * 0.8f;
    }
    const int row = w * 16 + l15;
    if (row < anq) {
#pragma unroll
      for (int dt = 0; dt < NDT; ++dt) {
        const int col = dt * 16 + quad * 4;
        uint2 g = *(const uint2*)(agate + (long)row * aldg + col);
        float g0 = bf_lo(g.x), g1 = bf_hi(g.x), g2 = bf_lo(g.y), g3 = bf_hi(g.y);
        if (NMAP == 2) { float4 gs = *(const float4*)(agsub + col); g0 *= gs.x; g1 *= gs.y; g2 *= gs.z; g3 *= gs.w; }
        uint2 o = {pack2(O[0][dt][0] * r * g0, O[0][dt][1] * r * g1), pack2(O[0][dt][2] * r * g2, O[0][dt][3] * r * g3)};
        *(uint2*)(aout + (long)row * aldo + col) = o;
      }
    }
  }
}

struct MlstmArgs {
  const u16* Z; int nchunk; int nvalid;
  const float* gif;
  int h;
  const float* C0; const float* n0; float m0; bool has_state;
  u16* mix; long ldm;
  const float* g_mh;
  float* oC; float* oN; float* oM;
};

DI void mlstm_item(const u16* aZ, int anchunk, int anvalid, const float* agif, int ah, const float* aC0, const float* an0, float am0,
                   bool ahas_state, u16* amix, long aldm, const float* ag_mh, float* aoC, float* aoN, float* aoM, char* smem) {
  int tid = threadIdx.x; asm volatile("" : "+v"(tid));
  const int lane = tid & 63, w = tid >> 6;
  const int l15 = lane & 15, quad = lane >> 4;
  const int q4 = l15 >> 2, p4 = l15 & 3;
  constexpr int RS = 160;
  constexpr int TB = 64 * RS;
  constexpr int STG = 3 * TB;
  char* ct = smem + 2 * STG;
  float* ga = (float*)(ct + 80 * RS);
  constexpr int GST = 5 * 64 + 4;
  const bool roleB = w >= 4;
  const int wb = w & 3;
  f32x4 Cacc[5];
#pragma unroll
  for (int dt = 0; dt < 5; ++dt) Cacc[dt] = (f32x4){0.f, 0.f, 0.f, 0.f};
  if (ahas_state && roleB) {
#pragma unroll
    for (int dt = 0; dt < 4; ++dt)
#pragma unroll
      for (int j = 0; j < 4; ++j) Cacc[dt][j] = aC0[(16 * wb + quad * 4 + j) * 64 + dt * 16 + l15];
    if (l15 == 0) {
#pragma unroll
      for (int j = 0; j < 4; ++j) Cacc[4][j] = an0[16 * wb + quad * 4 + j];
    }
  }
  float m0 = am0;
  float pig = 0.f, plf = 0.f;
  const bool gvalid = lane < anvalid;
#define MLSTM_GLOAD(c_) do { \
    const float* gp_ = agif + ((long)(c_) * 64 + (gvalid ? lane : 0)) * 8; \
    pig = gvalid ? gp_[ah] : -INFINITY; plf = gvalid ? gp_[4 + ah] : 0.f; \
  } while (0)
#define MLSTM_SCAN(stage_) do { \
    float* g_ = ga + (stage_) * GST; \
    float b_ = plf; \
    _Pragma("unroll") for (int o = 1; o < 64; o <<= 1) { float u_ = __shfl_up(b_, o); if (lane >= o) b_ += u_; } \
    const float av_ = pig - b_; \
    float pm_ = av_; \
    _Pragma("unroll") for (int o = 1; o < 64; o <<= 1) { float u_ = __shfl_up(pm_, o); if (lane >= o) pm_ = fmaxf(pm_, u_); } \
    const float M_ = fmaxf(m0, pm_); \
    const float ML_ = __shfl(M_, 63), bL_ = __shfl(b_, 63); \
    g_[lane] = av_ * LOG2E; g_[64 + lane] = M_ * LOG2E; g_[128 + lane] = expf(-(b_ + M_)); \
    g_[192 + lane] = expf(m0 - M_); g_[256 + lane] = expf(av_ - ML_); \
    if (lane == 0) g_[320] = expf(m0 - ML_); \
    m0 = bL_ + ML_; \
  } while (0)
#define MLSTM_WRITE_CT() do { \
    _Pragma("unroll") for (int dt = 0; dt < 5; ++dt) { \
      uint2 o_ = {pack2(Cacc[dt][0], Cacc[dt][1]), pack2(Cacc[dt][2], Cacc[dt][3])}; \
      *(uint2*)(ct + (dt * 16 + l15) * RS + (16 * wb + quad * 4) * 2) = o_; \
    } } while (0)
  uint4 rq0, rk0, rv0;
  const int ld_row = tid >> 3, ld_cc = tid & 7;
#define MLSTM_LOADC(c_) do { \
    const int rr_ = ld_row < anvalid ? ld_row : anvalid - 1; \
    const u16* b0_ = aZ + ((long)(c_) * 64 + rr_) * NZ + ah * 64 + ld_cc * 8; \
    rq0 = *(const uint4*)(b0_ + 2048); rk0 = *(const uint4*)(b0_ + 2304); rv0 = *(const uint4*)(b0_ + 2560); \
  } while (0)
#define MLSTM_STOREC(stage_) do { \
    char* sb_ = smem + (stage_) * STG + ld_row * RS + ld_cc * 16; \
    *(uint4*)(sb_) = rq0; *(uint4*)(sb_ + TB) = rk0; *(uint4*)(sb_ + 2 * TB) = rv0; \
  } while (0)
  if (roleB) MLSTM_WRITE_CT();
  MLSTM_LOADC(0); MLSTM_STOREC(0);
  if (w == 4) { MLSTM_GLOAD(0); MLSTM_SCAN(0); }
  __syncthreads();
  const unsigned ones = (l15 == 0) ? 0x3F803F80u : 0u;
  const bf16x8 onesf = mk_frag(ones, ones, ones, ones);
  for (int c = 0; c < anchunk; ++c) {
    const int stage = c & 1;
    const int cn = c + 1 < anchunk ? c + 1 : c;
    MLSTM_LOADC(cn);
    if (w == 4) MLSTM_GLOAD(cn);
    const char* sq = smem + stage * STG; const char* sk = sq + TB; const char* sv = sq + 2 * TB;
    const float* g = ga + stage * GST;
    if (!roleB) {
      const int t = 16 * w + l15;
      const float M2t = g[64 + t], emt = g[128 + t], gwt = g[192 + t];
      bf16x8 qf0 = ld_frag(sq + t * RS + quad * 16), qf1 = ld_frag(sq + t * RS + (4 + quad) * 16);
      f32x4 pt[4];
#pragma unroll
      for (int st = 0; st < 4; ++st) {
        pt[st] = (f32x4){0.f, 0.f, 0.f, 0.f};
        if (st <= w) {
          const char* kr = sk + (st * 16 + l15) * RS;
          f32x4 z = {0.f, 0.f, 0.f, 0.f};
          z = MFMA(ld_frag(kr + quad * 16), qf0, z);
          z = MFMA(ld_frag(kr + (4 + quad) * 16), qf1, z);
          float4 a2 = *(const float4*)(g + st * 16 + quad * 4);
          const float av[4] = {a2.x, a2.y, a2.z, a2.w};
#pragma unroll
          for (int j = 0; j < 4; ++j) {
            const int sidx = st * 16 + quad * 4 + j;
            const float dw = (sidx <= t) ? ex2(av[j] - M2t) : 0.f;
            pt[st][j] = z[j] * dw;
          }
        }
      }
      bf16x8 pf[2];
#pragma unroll
      for (int ks2 = 0; ks2 < 2; ++ks2)
        pf[ks2] = mk_frag(pack2(pt[2 * ks2][0], pt[2 * ks2][1]), pack2(pt[2 * ks2][2], pt[2 * ks2][3]),
                          pack2(pt[2 * ks2 + 1][0], pt[2 * ks2 + 1][1]), pack2(pt[2 * ks2 + 1][2], pt[2 * ks2 + 1][3]));
      f32x4 H[5];
      const char* vl = sv + (quad * 4 + q4) * RS + p4 * 8;
#pragma unroll
      for (int dt = 0; dt < 5; ++dt) {
        const char* cr = ct + (dt * 16 + l15) * RS;
        f32x4 z = {0.f, 0.f, 0.f, 0.f};
        z = MFMA(ld_frag(cr + quad * 16), qf0, z);
        z = MFMA(ld_frag(cr + (4 + quad) * 16), qf1, z);
        z *= gwt;
#pragma unroll
        for (int ks2 = 0; ks2 < 2; ++ks2) {
          bf16x8 vf = (dt < 4) ? tr_frag(vl + ks2 * 32 * RS + dt * 32, 16 * RS) : onesf;
          z = MFMA(vf, pf[ks2], z);
        }
        H[dt] = z;
      }
      const float den = __shfl(H[4][0], l15);
      const float sc = 1.f / fmaxf(fabsf(den), emt);
      float ss = 0.f;
#pragma unroll
      for (int dt = 0; dt < 4; ++dt)
#pragma unroll
        for (int j = 0; j < 4; ++j) { float hv = H[dt][j] * sc; H[dt][j] = hv; ss += hv * hv; }
      ss += __shfl_xor(ss, 16); ss += __shfl_xor(ss, 32);
      const float r = rsqrtf(ss * (1.f / 64.f) + EPS);
      if (t < anvalid) {
        const u16* zr = aZ + ((long)c * 64 + t) * NZ + ah * 64;
        u16* mr = amix + ((long)c * 64 + t) * aldm + 512 + ah * 64;
#pragma unroll
        for (int dt = 0; dt < 4; ++dt) {
          const int col = dt * 16 + quad * 4;
          uint2 ob = *(const uint2*)(zr + 2816 + col);
          uint2 gb = *(const uint2*)(zr + 3072 + col);
          float4 gm = *(const float4*)(ag_mh + col);
          float o0 = H[dt][0] * r * gm.x * bf_lo(ob.x) * bf_lo(gb.x);
          float o1 = H[dt][1] * r * gm.y * bf_hi(ob.x) * bf_hi(gb.x);
          float o2 = H[dt][2] * r * gm.z * bf_lo(ob.y) * bf_lo(gb.y);
          float o3 = H[dt][3] * r * gm.w * bf_hi(ob.y) * bf_hi(gb.y);
          uint2 o = {pack2(o0, o1), pack2(o2, o3)};
          *(uint2*)(mr + col) = o;
        }
      }
    } else {
      const float decay = g[320];
#pragma unroll
      for (int dt = 0; dt < 5; ++dt) Cacc[dt] *= decay;
      const char* kl = sk + (quad * 8 + q4) * RS + 16 * wb * 2 + p4 * 8;
      const char* vl2 = sv + (quad * 8 + q4) * RS + p4 * 8;
#pragma unroll
      for (int ks2 = 0; ks2 < 2; ++ks2) {
        uint2 ka = tr_read(kl + ks2 * 32 * RS), kb2 = tr_read(kl + ks2 * 32 * RS + 4 * RS);
        float4 w0 = *(const float4*)(g + 256 + ks2 * 32 + quad * 8), w1 = *(const float4*)(g + 256 + ks2 * 32 + quad * 8 + 4);
        bf16x8 kw = mk_frag(pack2(bf_lo(ka.x) * w0.x, bf_hi(ka.x) * w0.y), pack2(bf_lo(ka.y) * w0.z, bf_hi(ka.y) * w0.w),
                            pack2(bf_lo(kb2.x) * w1.x, bf_hi(kb2.x) * w1.y), pack2(bf_lo(kb2.y) * w1.z, bf_hi(kb2.y) * w1.w));
#pragma unroll
        for (int dt = 0; dt < 5; ++dt) {
          bf16x8 vf = (dt < 4) ? tr_frag(vl2 + ks2 * 32 * RS + dt * 32, 4 * RS) : onesf;
          Cacc[dt] = MFMA(kw, vf, Cacc[dt]);
        }
      }
    }
    __syncthreads();
    if (roleB) MLSTM_WRITE_CT();
    MLSTM_STOREC((c + 1) & 1);
    if (c + 1 < anchunk && w == 4) MLSTM_SCAN((c + 1) & 1);
    __syncthreads();
  }
  if (roleB) {
#pragma unroll
    for (int dt = 0; dt < 4; ++dt)
#pragma unroll
      for (int j = 0; j < 4; ++j) aoC[(16 * wb + quad * 4 + j) * 64 + dt * 16 + l15] = Cacc[dt][j];
    if (l15 == 0) {
#pragma unroll
      for (int j = 0; j < 4; ++j) aoN[16 * wb + quad * 4 + j] = Cacc[4][j];
    }
    if (tid == 256) *aoM = m0;
  }
}

DI int next_item(int* counter, int* s_item) {
  __syncthreads();
  if (threadIdx.x == 0) *s_item = atomicAdd(counter, 1);
  __syncthreads();
  return *s_item;
}

DI void phase2(const Params& p, char* smem, int cbase) {
  char* ws = p.ws;
  int* s_item = (int*)(smem + LDS_BYTES - 16);
  int* counters = (int*)(ws + WS_CTL) + cbase;
  const u16* Z = (const u16*)(ws + WS_Z); const u16* ZS = (const u16*)(ws + WS_ZS);
  u16* MIX = (u16*)(ws + WS_MIX); u16* MIXS = (u16*)(ws + WS_MIXS);
  while (true) {
    const int it = next_item(counters + 4, s_item);
    if (it >= 160) break;
    if (it < 128) {
      const int b = it >> 2, h = it & 3;
      mlstm_item(Z + (long)b * 2048 * NZ, 32, 64, (const float*)(ws + WS_GIF) + (long)b * 2048 * 8, h, p.sC, p.sN, 0.f, false,
                 MIX + (long)b * 2048 * 1024, 1024, p.g_mh, p.out + O_PC + (long)(b * 4 + h) * 4096, p.out + O_PN + (b * 4 + h) * 64,
                 p.out + O_PM + b * 4 + h, smem);
    } else {
      const int u = it - 128; const int b = u >> 2, h = u & 3;
      mlstm_item(ZS + (long)b * 16 * NZ, 1, 16, (const float*)(ws + WS_GIFS) + (long)b * 16 * 8, h, p.sC + (long)(b * 4 + h) * 4096,
                 p.sN + (b * 4 + h) * 64, p.sM[b * 4 + h], true, MIXS + (long)b * 16 * 1024, 1024, p.g_mh,
                 p.out + O_SC + (long)(b * 4 + h) * 4096, p.out + O_SN + (b * 4 + h) * 64, p.out + O_SM + b * 4 + h, smem);
    }
  }
  {
    const float lam = ((const float*)(ws + WS_CTL))[1];
    while (true) {
      const int it = next_item(counters + 8, s_item);
      if (it >= 32 + 2048) break;
      const u16 *aQ, *aK, *aV, *agate; u16* aout; long ldq, ldk; int nq, nkeys, tlo, thi, qpos0, h;
      if (it < 32) {
        const int b = it >> 2; h = it & 3;
        aQ = ZS + (long)b * 16 * NZ + h * 128; ldq = NZ; nq = 16;
        aK = (const u16*)(ws + WS_KS) + (long)b * SKS * 512 + h * 128; aV = (const u16*)(ws + WS_VS) + (long)b * SKS * 512 + h * 128;
        ldk = 512; nkeys = SKS; tlo = 33; thi = 33; qpos0 = 2048;
        agate = ZS + (long)b * 16 * NZ + 1536 + h * 128; aout = MIXS + (long)b * 16 * 1024 + h * 128;
      } else {
        const int u = it - 32; const int qb = 15 - (u >> 7); const int bh = u & 127; const int b = bh >> 2; h = bh & 3;
        const long tok0 = (long)b * 2048 + qb * 128;
        aQ = Z + tok0 * NZ + h * 128; ldq = NZ; nq = 128;
        aK = Z + (long)b * 2048 * NZ + 512 + h * 128; aV = Z + (long)b * 2048 * NZ + 1024 + h * 128;
        ldk = NZ; nkeys = 2048; tlo = 2 * qb + 1; thi = 2 * qb + 2; qpos0 = qb * 128;
        agate = Z + tok0 * NZ + 1536 + h * 128; aout = MIX + tok0 * 1024 + h * 128;
      }
      attn_item<2, 128, true>(aQ, ldq, nq, aK, aV, ldk, ldk, nkeys, tlo, thi, qpos0, exp2f(-2.f * (h + 1)) * LOG2E, lam, agate, NZ,
                              aout, 1024, p.g_subln, smem);
    }
  }
  while (true) {
    const int it = next_item(counters + 12, s_item);
    if (it >= 2048 + 32) break;
    const u16 *aQ, *aK, *agate; u16* aout; int nq;
    if (it < 2048) {
      const int tb = it >> 2, h = it & 3; const int b = tb >> 4;
      const long tok0 = (long)tb * 128;
      aQ = Z + tok0 * NZ + 3328 + h * 64; nq = 128;
      aK = (const u16*)(ws + WS_MKV) + (long)b * 256 * 512 + h * 64;
      agate = Z + tok0 * NZ + 3584 + h * 64; aout = MIX + tok0 * 1024 + 768 + h * 64;
    } else {
      const int u = it - 2048; const int b = u >> 2, h = u & 3;
      aQ = ZS + (long)b * 16 * NZ + 3328 + h * 64; nq = 16;
      aK = (const u16*)(ws + WS_MKVS) + (long)b * 256 * 512 + h * 64;
      agate = ZS + (long)b * 16 * NZ + 3584 + h * 64; aout = MIXS + (long)b * 16 * 1024 + 768 + h * 64;
    }
    attn_item<1, 64, false>(aQ, NZ, nq, aK, aK + 256, 512, 512, 256, 4, 4, 0, 0.f, 0.f, agate, NZ, aout, 1024, p.g_subln, smem);
  }
}

__global__ void __launch_bounds__(512) fwd_megakernel(Params p, int phase_lo, int phase_hi, int coop) {
  extern __shared__ __attribute__((aligned(16))) char smem[];
  cg::grid_group grid = cg::this_grid();
  if (phase_lo <= 0 && phase_hi > 0) phase0(p, smem);
#if PROBE_DUP == 4
  __syncthreads();
  if (phase_lo <= 0 && phase_hi > 0) phase0(p, smem);
#endif
  if (coop) { __threadfence(); grid.sync(); }
  if (phase_lo <= 1 && phase_hi > 1) phase1(p, smem);
#if PROBE_DUP == 1
  if (phase_lo <= 1 && phase_hi > 1) phase1(p, smem);
#endif
  if (coop) { __threadfence(); grid.sync(); }
  if (phase_lo <= 2 && phase_hi > 2) phase2(p, smem, 0);
#if PROBE_DUP == 2
  if (phase_lo <= 2 && phase_hi > 2) phase2(p, smem, 16);
#endif
  if (coop) { __threadfence(); grid.sync(); }
  if (phase_lo <= 3 && phase_hi > 3) phase3(p, smem);
#if PROBE_DUP == 3
  if (phase_lo <= 3 && phase_hi > 3) phase3(p, smem);
#endif
}

extern "C" void kernel_launch(void* const* d_in, const int* in_sizes, int n_in, void* d_out, int out_size,
                              void* d_ws, size_t ws_size, hipStream_t stream) {
  static int grid_blocks = 0;
  if (!grid_blocks) {
    int dev = 0, cus = 0, per_cu = 0;
    (void)hipGetDevice(&dev);
    (void)hipDeviceGetAttribute(&cus, hipDeviceAttributeMultiprocessorCount, dev);
    (void)hipFuncSetAttribute((const void*)fwd_megakernel, hipFuncAttributeMaxDynamicSharedMemorySize, LDS_BYTES);
    (void)hipOccupancyMaxActiveBlocksPerMultiprocessor(&per_cu, fwd_megakernel, 512, LDS_BYTES);
    if (per_cu < 1) per_cu = 1;
    if (per_cu > 1) per_cu = 1;
    grid_blocks = cus * per_cu;
    if (ws_size < WS_END) fprintf(stderr, "workspace too small: %zu < %zu\n", ws_size, (size_t)WS_END);
  }
  Params p{};
  const float** pp = (const float**)&p;
  for (int i = 0; i < 28; ++i) pp[i] = (const float*)d_in[i];
  p.out = (float*)d_out; p.ws = (char*)d_ws;
  int lo = 0, hi = 4, coop = 1;
  void* args[] = {&p, &lo, &hi, &coop};
  hipError_t e = hipLaunchCooperativeKernel((void*)fwd_megakernel, dim3(grid_blocks), dim3(512), args, LDS_BYTES, stream);
  if (e != hipSuccess) fprintf(stderr, "cooperative launch failed: %s (grid %d)\n", hipGetErrorString(e), grid_blocks);
}
```

```cpp
#include <hip/hip_runtime.h>
#include <hip/hip_cooperative_groups.h>
#include <cstdio>
namespace cg = cooperative_groups;

typedef unsigned short u16;
typedef short bf16x8 __attribute__((ext_vector_type(8)));
typedef short s16x4 __attribute__((ext_vector_type(4)));
typedef float f32x4 __attribute__((ext_vector_type(4)));
typedef float f32x2 __attribute__((ext_vector_type(2)));
typedef __bf16 bf16x2_t __attribute__((ext_vector_type(2)));
#define DI __device__ __forceinline__
#define MFMA(a, b, c) __builtin_amdgcn_mfma_f32_16x16x32_bf16((a), (b), (c), 0, 0, 0)

constexpr int DM = 1024;
constexpr int TP = 65536;
constexpr int TS = 128;
constexpr int TMEM = 8192;
constexpr int NZ = 3840;
constexpr int NIN = 3848;
constexpr int SKS = 2064;
constexpr float EPS = 1e-6f;
constexpr float LOG2E = 1.4426950408889634f;
constexpr float QSCALE = 0.125f * LOG2E;

constexpr size_t WS_CTL = 0;
constexpr size_t WS_WTIN = 4096;
constexpr size_t WS_WTOUT = WS_WTIN + (size_t)NZ * 1024 * 2;
constexpr size_t WS_WTM = WS_WTOUT + (size_t)1024 * 1024 * 2;
constexpr size_t WS_XB = WS_WTM + (size_t)512 * 1024 * 2;
constexpr size_t WS_XSB = WS_XB + (size_t)TP * 1024 * 2;
constexpr size_t WS_MB = WS_XSB + (size_t)TS * 1024 * 2;
constexpr size_t WS_RSTD = WS_MB + (size_t)TMEM * 1024 * 2;
constexpr size_t WS_RSTDS = WS_RSTD + (size_t)TP * 4;
constexpr size_t WS_RSTDM = WS_RSTDS + (size_t)TS * 4;
constexpr size_t WS_GIF = WS_RSTDM + (size_t)TMEM * 4;
constexpr size_t WS_GIFS = WS_GIF + (size_t)TP * 8 * 4;
constexpr size_t WS_Z = WS_GIFS + (size_t)TS * 8 * 4;
constexpr size_t WS_ZS = WS_Z + (size_t)TP * NZ * 2;
constexpr size_t WS_MIX = WS_ZS + (size_t)TS * NZ * 2;
constexpr size_t WS_MIXS = WS_MIX + (size_t)TP * 1024 * 2;
constexpr size_t WS_KS = WS_MIXS + (size_t)TS * 1024 * 2;
constexpr size_t WS_VS = WS_KS + (size_t)8 * SKS * 512 * 2;
constexpr size_t WS_MKV = WS_VS + (size_t)8 * SKS * 512 * 2;
constexpr size_t WS_MKVS = WS_MKV + (size_t)TMEM * 512 * 2;
constexpr size_t WS_END = WS_MKVS + (size_t)2048 * 512 * 2;

constexpr long O_Y = 0;
constexpr long O_YS = O_Y + 67108864L;
constexpr long O_PK = O_YS + 131072L;
constexpr long O_PV = O_PK + 33554432L;
constexpr long O_PC = O_PV + 33554432L;
constexpr long O_PN = O_PC + 524288L;
constexpr long O_PM = O_PN + 8192L;
constexpr long O_PMK = O_PM + 128L;
constexpr long O_PMV = O_PMK + 2097152L;
constexpr long O_SK = O_PMV + 2097152L;
constexpr long O_SV = O_SK + 65536L;
constexpr long O_SC = O_SV + 65536L;
constexpr long O_SN = O_SC + 131072L;
constexpr long O_SM = O_SN + 2048L;

constexpr int LDS_BYTES = 143360;
constexpr int NT = 512;
constexpr int NWV = 8;
#ifndef STAG1
#define STAG1 350
#endif
#ifndef STAG3
#define STAG3 450
#endif
#ifndef PROBE_DUP
#define PROBE_DUP 0
#endif

struct Params {
  const float* x; const float* xs; const float* ck; const float* cv; const float* sC; const float* sN; const float* sM;
  const float* cmk; const float* cmv; const float* mem; const float* g_norm; const float* w_in; const float* w_out;
  const float* g_qa; const float* g_ka; const float* lq1; const float* lk1; const float* lq2; const float* lk2;
  const float* g_subln; const float* b_i; const float* b_f; const float* g_mh; const float* g_qm; const float* g_km;
  const float* g_mem; const float* w_mk; const float* w_mv;
  float* out; char* ws;
};

DI unsigned pack2(float a, float b) { f32x2 v = {a, b}; return __builtin_bit_cast(unsigned, __builtin_convertvector(v, bf16x2_t)); }
DI float bf_lo(unsigned u) { return __uint_as_float(u << 16); }
DI float bf_hi(unsigned u) { return __uint_as_float(u & 0xffff0000u); }
DI float ex2(float x) { return __builtin_amdgcn_exp2f(x); }
DI bf16x8 ld_frag(const char* p) { return __builtin_bit_cast(bf16x8, *(const uint4*)p); }
DI bf16x8 mk_frag(unsigned a, unsigned b, unsigned c, unsigned d) { uint4 v = {a, b, c, d}; return __builtin_bit_cast(bf16x8, v); }
DI uint2 tr_read(const char* p) {
  s16x4 r = __builtin_amdgcn_ds_read_tr16_b64_v4i16((__attribute__((address_space(3))) s16x4*)(p));
  return __builtin_bit_cast(uint2, r);
}
DI bf16x8 tr_frag(const char* p, int off2) { uint2 a = tr_read(p), b = tr_read(p + off2); return mk_frag(a.x, a.y, b.x, b.y); }
DI float wave_sum(float v) {
#pragma unroll
  for (int o = 32; o > 0; o >>= 1) v += __shfl_xor(v, o);
  return v;
}
DI float silu_f(float x) { return x * __builtin_amdgcn_rcpf(1.f + __expf(-x)); }
DI float sigm_f(float x) { return __builtin_amdgcn_rcpf(1.f + __expf(-x)); }

DI void phase0(const Params& p, char* smem) {
  const int tid = threadIdx.x, lane = tid & 63, wave = tid >> 6;
  char* ws = p.ws;
  if (blockIdx.x == 0 && wave == 0) {
    float a = wave_sum(p.lq1[lane] * p.lk1[lane]);
    float b = wave_sum(p.lq2[lane] * p.lk2[lane]);
    if (lane == 0) {
      ((int*)(ws + WS_CTL))[4] = 0; ((int*)(ws + WS_CTL))[8] = 0; ((int*)(ws + WS_CTL))[12] = 0;
      ((int*)(ws + WS_CTL))[32] = 0; ((int*)(ws + WS_CTL))[36] = 0;
      for (int q = 40; q < 48; ++q) ((int*)(ws + WS_CTL))[q] = 0;
      ((int*)(ws + WS_CTL))[20] = 0; ((int*)(ws + WS_CTL))[24] = 0; ((int*)(ws + WS_CTL))[28] = 0;
      ((float*)(ws + WS_CTL))[1] = expf(a) - expf(b) + 0.2f;
    }
  }
  float* WG = (float*)smem;
  for (int k = tid; k < 1024; k += NT) {
    float g = p.g_norm[k];
    float4 a = *(const float4*)(p.w_in + (long)k * NIN + 3072);
    float4 b = *(const float4*)(p.w_in + (long)k * NIN + 3076);
    float4 a2 = {a.x * g, a.y * g, a.z * g, a.w * g}, b2 = {b.x * g, b.y * g, b.z * g, b.w * g};
    *(float4*)(WG + k * 8) = a2; *(float4*)(WG + k * 8 + 4) = b2;
  }
  __syncthreads();
  {
    constexpr int RPW = 4;
    const int gw = blockIdx.x * NWV + wave, nw = gridDim.x * NWV;
    constexpr int NROWS = TP + TS + TMEM;
    for (int r0 = gw; r0 < NROWS; r0 += RPW * nw) {
      const float* src[RPW]; u16* dst[RPW]; float* rsp[RPW]; float* gif[RPW]; bool live[RPW];
#pragma unroll
      for (int q = 0; q < RPW; ++q) {
        int r = r0 + q * nw; live[q] = r < NROWS; r = live[q] ? r : r0;
        if (r < TP) { src[q] = p.x + (long)r * 1024; dst[q] = (u16*)(ws + WS_XB) + (long)r * 1024; rsp[q] = (float*)(ws + WS_RSTD) + r; gif[q] = (float*)(ws + WS_GIF) + (long)r * 8; }
        else if (r < TP + TS) { int u = r - TP; src[q] = p.xs + (long)u * 1024; dst[q] = (u16*)(ws + WS_XSB) + (long)u * 1024; rsp[q] = (float*)(ws + WS_RSTDS) + u; gif[q] = (float*)(ws + WS_GIFS) + (long)u * 8; }
        else { int u = r - TP - TS; src[q] = p.mem + (long)u * 1024; dst[q] = (u16*)(ws + WS_MB) + (long)u * 1024; rsp[q] = (float*)(ws + WS_RSTDM) + u; gif[q] = nullptr; }
      }
      float4 vv[RPW][4];
#pragma unroll
      for (int q = 0; q < RPW; ++q)
#pragma unroll
        for (int i = 0; i < 4; ++i) { const f32x4 t_ = __builtin_nontemporal_load((const f32x4*)(src[q] + (i >> 1) * 512 + lane * 8 + (i & 1) * 4)); vv[q][i] = make_float4(t_[0], t_[1], t_[2], t_[3]); }
      float ss[RPW];
#pragma unroll
      for (int q = 0; q < RPW; ++q) {
        ss[q] = 0.f;
#pragma unroll
        for (int i = 0; i < 4; ++i) ss[q] += vv[q][i].x * vv[q][i].x + vv[q][i].y * vv[q][i].y + vv[q][i].z * vv[q][i].z + vv[q][i].w * vv[q][i].w;
      }
#pragma unroll
      for (int o = 32; o > 0; o >>= 1)
#pragma unroll
        for (int q = 0; q < RPW; ++q) ss[q] += __shfl_xor(ss[q], o);
      float rstd[RPW];
#pragma unroll
      for (int q = 0; q < RPW; ++q) {
        rstd[q] = rsqrtf(ss[q] * (1.f / 1024.f) + EPS);
        if (live[q]) {
#pragma unroll
          for (int hh = 0; hh < 2; ++hh) { uint4 o_ = {pack2(vv[q][2 * hh].x, vv[q][2 * hh].y), pack2(vv[q][2 * hh].z, vv[q][2 * hh].w), pack2(vv[q][2 * hh + 1].x, vv[q][2 * hh + 1].y), pack2(vv[q][2 * hh + 1].z, vv[q][2 * hh + 1].w)}; *(uint4*)(dst[q] + hh * 512 + lane * 8) = o_; }
          if (lane == 0) *rsp[q] = rstd[q];
        }
      }
      if (gif[0] || gif[RPW - 1]) {
        float g[RPW][8];
#pragma unroll
        for (int q = 0; q < RPW; ++q)
#pragma unroll
          for (int j = 0; j < 8; ++j) g[q][j] = 0.f;
#pragma unroll
        for (int i = 0; i < 4; ++i)
#pragma unroll
          for (int e = 0; e < 4; ++e) {
            const float* wr = WG + ((i >> 1) * 512 + lane * 8 + (i & 1) * 4 + e) * 8;
            const float4 wa = *(const float4*)wr, wb = *(const float4*)(wr + 4);
#pragma unroll
            for (int q = 0; q < RPW; ++q) {
              const float xv = e == 0 ? vv[q][i].x : (e == 1 ? vv[q][i].y : (e == 2 ? vv[q][i].z : vv[q][i].w));
              g[q][0] += xv * wa.x; g[q][1] += xv * wa.y; g[q][2] += xv * wa.z; g[q][3] += xv * wa.w;
              g[q][4] += xv * wb.x; g[q][5] += xv * wb.y; g[q][6] += xv * wb.z; g[q][7] += xv * wb.w;
            }
          }
        const bool hi = (lane & 32) != 0, h2 = (lane & 16) != 0, h3 = (lane & 8) != 0;
        float c0[RPW];
#pragma unroll
        for (int q = 0; q < RPW; ++q) {
          float a0 = hi ? g[q][4] : g[q][0], a1 = hi ? g[q][5] : g[q][1], a2 = hi ? g[q][6] : g[q][2], a3 = hi ? g[q][7] : g[q][3];
          const float s0 = hi ? g[q][0] : g[q][4], s1 = hi ? g[q][1] : g[q][5], s2 = hi ? g[q][2] : g[q][6], s3 = hi ? g[q][3] : g[q][7];
          a0 += __shfl_xor(s0, 32); a1 += __shfl_xor(s1, 32); a2 += __shfl_xor(s2, 32); a3 += __shfl_xor(s3, 32);
          float b0 = h2 ? a2 : a0, b1 = h2 ? a3 : a1;
          const float t0 = h2 ? a0 : a2, t1 = h2 ? a1 : a3;
          b0 += __shfl_xor(t0, 16); b1 += __shfl_xor(t1, 16);
          float c = h3 ? b1 : b0; const float u0 = h3 ? b0 : b1;
          c += __shfl_xor(u0, 8);
          c0[q] = c;
        }
#pragma unroll
        for (int o = 4; o > 0; o >>= 1)
#pragma unroll
          for (int q = 0; q < RPW; ++q) c0[q] += __shfl_xor(c0[q], o);
        const int jg = 4 * (lane >> 5) + 2 * ((lane >> 4) & 1) + ((lane >> 3) & 1);
        const float bias = jg < 4 ? p.b_i[jg] : p.b_f[jg - 4];
#pragma unroll
        for (int q = 0; q < RPW; ++q) {
          if (live[q] && gif[q] && (lane & 7) == 0) {
            const float xx = c0[q] * rstd[q] + bias;
            gif[q][jg] = jg < 4 ? xx : fminf(xx, 0.f) - log1pf(expf(-fabsf(xx)));
          }
        }
      }
    }
  }
  const long gtid = (long)blockIdx.x * NT + tid, nth = (long)gridDim.x * NT;
  {
    u16* wt = (u16*)(ws + WS_WTIN);
    for (long idx = gtid; idx < (long)NZ * 128; idx += nth) {
      int n = (int)(idx % NZ), kc = (int)(idx / NZ);
      int on = n < 3072 ? n : n + 8;
      float v[8];
#pragma unroll
      for (int e = 0; e < 8; ++e) v[e] = p.w_in[(long)(kc * 8 + e) * NIN + on] * p.g_norm[kc * 8 + e];
      uint4 o = {pack2(v[0], v[1]), pack2(v[2], v[3]), pack2(v[4], v[5]), pack2(v[6], v[7])};
      *(uint4*)(wt + (long)n * 1024 + kc * 8) = o;
    }
    u16* wm = (u16*)(ws + WS_WTM);
    for (long idx = gtid; idx < 512L * 128; idx += nth) {
      int n = (int)(idx % 512), kc = (int)(idx / 512);
      const float* src = n < 256 ? p.w_mk + n : p.w_mv + (n - 256);
      float v[8];
#pragma unroll
      for (int e = 0; e < 8; ++e) v[e] = src[(long)(kc * 8 + e) * 256] * p.g_mem[kc * 8 + e];
      uint4 o = {pack2(v[0], v[1]), pack2(v[2], v[3]), pack2(v[4], v[5]), pack2(v[6], v[7])};
      *(uint4*)(wm + (long)n * 1024 + kc * 8) = o;
    }
  }
}

DI void phase1_late(const Params& p, char* smem) {
  const int tid = threadIdx.x;
  char* ws = p.ws;
  int* s_item = (int*)(smem + LDS_BYTES - 16);
  int* counter = (int*)(ws + WS_CTL) + 36;
  constexpr long N_WO = 1024L * 128, N_KV = 2L * 8 * 2048 * 64, N_MK = 2L * 2048 * 32;
  constexpr int CH = 8192;
  constexpr int NCH = (int)((N_WO + N_KV + N_MK + CH - 1) / CH);
  u16* wo = (u16*)(ws + WS_WTOUT);
  u16* ks = (u16*)(ws + WS_KS); u16* vs = (u16*)(ws + WS_VS);
  u16* mk = (u16*)(ws + WS_MKVS);
  while (true) {
    __syncthreads();
    if (tid == 0) *s_item = atomicAdd(counter, 1);
    __syncthreads();
    const int ch = __builtin_amdgcn_readfirstlane(*s_item);
    if (ch >= NCH) break;
#pragma unroll 4
    for (int i = 0; i < CH / NT; ++i) {
      long idx = (long)ch * CH + i * NT + tid;
      if (idx < N_WO) {
        int n = (int)(idx % 1024), kc = (int)(idx / 1024);
        float v[8];
#pragma unroll
        for (int e = 0; e < 8; ++e) v[e] = p.w_out[(long)(kc * 8 + e) * 1024 + n];
        uint4 o = {pack2(v[0], v[1]), pack2(v[2], v[3]), pack2(v[4], v[5]), pack2(v[6], v[7])};
        *(uint4*)(wo + (long)n * 1024 + kc * 8) = o;
      } else if (idx < N_WO + N_KV) {
        long id = idx - N_WO; const float* srcb = p.ck; u16* dstb = ks;
        if (id >= 8L * 2048 * 64) { id -= 8L * 2048 * 64; srcb = p.cv; dstb = vs; }
        int c = (int)(id & 63); long row = id >> 6; int b = (int)(row >> 11); int rr = (int)(row & 2047);
        const float* sp = srcb + row * 512 + c * 8;
        float4 a = *(const float4*)sp, bb = *(const float4*)(sp + 4);
        uint4 o = {pack2(a.x, a.y), pack2(a.z, a.w), pack2(bb.x, bb.y), pack2(bb.z, bb.w)};
        *(uint4*)(dstb + ((long)b * SKS + rr) * 512 + c * 8) = o;
      } else if (idx < N_WO + N_KV + N_MK) {
        long id = idx - N_WO - N_KV; const float* srcb = p.cmk; int coff = 0;
        if (id >= 2048L * 32) { id -= 2048L * 32; srcb = p.cmv; coff = 256; }
        int c = (int)(id & 31); long row = id >> 5;
        const float* sp = srcb + row * 256 + c * 8;
        float4 a = *(const float4*)sp, bb = *(const float4*)(sp + 4);
        uint4 o = {pack2(a.x, a.y), pack2(a.z, a.w), pack2(bb.x, bb.y), pack2(bb.z, bb.w)};
        *(uint4*)(mk + row * 512 + coff + c * 8) = o;
      }
    }
  }
}

struct EpiCfg {
  const float* rs; const float* gain; float post; int act;
  float* o32; long ld32; int c32;
  u16* ob; long ldb; int cb;
  u16* ob2; int c2;
  const float* resid;
};

DI void gemm_mainloop(const u16* __restrict__ A, int M, const u16* __restrict__ W, int m0, int n0, char* smem, f32x4 (&acc)[8][4], const u16* resid) {
  int tid = threadIdx.x; asm volatile("" : "+v"(tid));
  const int lane = tid & 63, wave = tid >> 6;
  const int l15 = lane & 15, quad = lane >> 4, l7 = lane & 7;
  const int wt = wave & 3, wf_ = wave >> 2;
  const int c8 = tid & 7, r0 = tid >> 3;
  if (resid) {
#pragma unroll
    for (int b = 0; b < 4; ++b) {
      int tok = m0 + wt * 64 + b * 16 + l15; tok = tok < M ? tok : M - 1;
      const u16* xr = resid + (long)tok * 1024 + n0 + wf_ * 128 + quad * 4;
#pragma unroll
      for (int a = 0; a < 8; ++a) { uint2 x2 = *(const uint2*)(xr + a * 16); acc[a][b] = (f32x4){bf_lo(x2.x), bf_hi(x2.x), bf_lo(x2.y), bf_hi(x2.y)}; }
    }
  } else {
#pragma unroll
    for (int a = 0; a < 8; ++a)
#pragma unroll
      for (int b = 0; b < 4; ++b) acc[a][b] = (f32x4){0.f, 0.f, 0.f, 0.f};
  }
  typedef unsigned u32x4_t __attribute__((ext_vector_type(4)));
  u32x4_t ra0, ra1, ra2, ra3, rw0, rw1, rw2, rw3;
  const int st_off = r0 * 128 + ((c8 ^ (r0 & 7)) * 16);
  int ar0 = m0 + r0, ar1 = m0 + r0 + 64, ar2 = m0 + r0 + 128, ar3 = m0 + r0 + 192;
  ar0 = ar0 < M ? ar0 : M - 1; ar1 = ar1 < M ? ar1 : M - 1; ar2 = ar2 < M ? ar2 : M - 1; ar3 = ar3 < M ? ar3 : M - 1;
  const __amdgpu_buffer_rsrc_t rsA = __builtin_amdgcn_make_buffer_rsrc((void*)A, 0, 0x7fffffff, 0x00020000);
  const __amdgpu_buffer_rsrc_t rsW = __builtin_amdgcn_make_buffer_rsrc((void*)W, 0, 0x7fffffff, 0x00020000);
  const int va0 = ar0 * 2048 + c8 * 16, va1 = ar1 * 2048 + c8 * 16, va2 = ar2 * 2048 + c8 * 16, va3 = ar3 * 2048 + c8 * 16;
  const int vw = (n0 + r0) * 2048 + c8 * 16;
#define GEMM_LOADK(kt_) do { const int so_ = (kt_) * 128; \
    ra0 = __builtin_amdgcn_raw_buffer_load_b128(rsA, va0, so_, 0); ra1 = __builtin_amdgcn_raw_buffer_load_b128(rsA, va1, so_, 0); \
    ra2 = __builtin_amdgcn_raw_buffer_load_b128(rsA, va2, so_, 0); ra3 = __builtin_amdgcn_raw_buffer_load_b128(rsA, va3, so_, 0); \
    rw0 = __builtin_amdgcn_raw_buffer_load_b128(rsW, vw, so_, 0); rw1 = __builtin_amdgcn_raw_buffer_load_b128(rsW, vw, so_ + 131072, 0); \
    rw2 = __builtin_amdgcn_raw_buffer_load_b128(rsW, vw, so_ + 262144, 0); rw3 = __builtin_amdgcn_raw_buffer_load_b128(rsW, vw, so_ + 393216, 0); \
  } while (0)
#define GEMM_STOREK(stage_) do { char* sa_ = smem + (stage_) * 65536 + st_off; char* sw_ = sa_ + 32768; \
    *(u32x4_t*)(sa_) = ra0; *(u32x4_t*)(sa_ + 8192) = ra1; *(u32x4_t*)(sa_ + 16384) = ra2; *(u32x4_t*)(sa_ + 24576) = ra3; \
    *(u32x4_t*)(sw_) = rw0; *(u32x4_t*)(sw_ + 8192) = rw1; *(u32x4_t*)(sw_ + 16384) = rw2; *(u32x4_t*)(sw_ + 24576) = rw3; \
  } while (0)
  GEMM_LOADK(0); GEMM_STOREK(0); __syncthreads();
  for (int kt = 0; kt < 16; ++kt) {
    GEMM_LOADK(kt + 1 < 16 ? kt + 1 : kt);
    __builtin_amdgcn_sched_barrier(0);
    const char* sa = smem + (kt & 1) * 65536; const char* sw = sa + 32768;
#pragma unroll
    for (int ks = 0; ks < 2; ++ks) {
      const int sw_off = ((ks * 4 + quad) ^ l7) * 16;
      bf16x8 wfr[8];
#pragma unroll
      for (int fi = 0; fi < 8; ++fi) wfr[fi] = ld_frag(sw + (wf_ * 128 + fi * 16 + l15) * 128 + sw_off);
#pragma unroll
      for (int ti = 0; ti < 4; ++ti) {
        const bf16x8 tf = ld_frag(sa + (wt * 64 + ti * 16 + l15) * 128 + sw_off);
#pragma unroll
        for (int fi = 0; fi < 8; ++fi) acc[fi][ti] = MFMA(wfr[fi], tf, acc[fi][ti]);
      }
    }
    GEMM_STOREK((kt + 1) & 1);
    __syncthreads();
  }
}

DI void load_rs(const float* rsp, int M, int m0, float (&rsv)[4]) {
  int tid = threadIdx.x; asm volatile("" : "+v"(tid));
  const int lane = tid & 63, wave = tid >> 6;
  const int l15 = lane & 15, wt = wave & 3;
#pragma unroll
  for (int ti = 0; ti < 4; ++ti) {
    const int tok = m0 + wt * 64 + ti * 16 + l15;
    rsv[ti] = rsp ? rsp[tok < M ? tok : M - 1] : 1.f;
  }
}

DI void stage_gains(const float* g0, const float* g1, char* smem) {
  int tid = threadIdx.x; asm volatile("" : "+v"(tid));
  const int lane = tid & 63, wave = tid >> 6;
  float* gl = (float*)(smem + 40960 + wave * 512);
  if (lane < 32) {
    const float* gp = lane < 16 ? g0 : g1;
    if (gp) *(float4*)(gl + lane * 4) = *(const float4*)(gp + (lane & 15) * 4);
  }
}

template <int H>
DI void gemm_epilogue(const EpiCfg& e, int M, int m0, f32x4 (&acc)[8][4], char* smem, const float (&rsv)[4]) {
  int tid = threadIdx.x; asm volatile("" : "+v"(tid));
  const int lane = tid & 63, wave = tid >> 6;
  const int l15 = lane & 15, quad = lane >> 4;
  const int wt = wave & 3;
  char* reg = smem + wave * 4352;
  const float* gl = (const float*)(smem + 40960 + wave * 512) + H * 64;
#pragma unroll
  for (int ti = 0; ti < 4; ++ti) {
    float v[4][4];
    {
      const float rs = rsv[ti];
#pragma unroll
      for (int fi = 0; fi < 4; ++fi)
#pragma unroll
        for (int j = 0; j < 4; ++j) v[fi][j] = acc[H * 4 + fi][ti][j] * rs;
      if (e.gain) {
        float ss = 0.f;
#pragma unroll
        for (int fi = 0; fi < 4; ++fi)
#pragma unroll
          for (int j = 0; j < 4; ++j) ss += v[fi][j] * v[fi][j];
        ss += __shfl_xor(ss, 16); ss += __shfl_xor(ss, 32);
        const float r = rsqrtf(ss * (1.f / 64.f) + EPS);
#pragma unroll
        for (int fi = 0; fi < 4; ++fi) {
          float4 g = *(const float4*)(gl + fi * 16 + quad * 4);
          v[fi][0] *= r * g.x; v[fi][1] *= r * g.y; v[fi][2] *= r * g.z; v[fi][3] *= r * g.w;
        }
      }
    }
    const int tokbase = m0 + wt * 64 + ti * 16;
    if (e.o32) {
#pragma unroll
      for (int fi = 0; fi < 4; ++fi) {
        float4 o = {v[fi][0], v[fi][1], v[fi][2], v[fi][3]};
        *(float4*)(reg + l15 * 272 + (fi * 16 + quad * 4) * 4) = o;
      }
#pragma unroll
      for (int i = 0; i < 4; ++i) {
        const int row = i * 4 + quad;
        float4 o = *(const float4*)(reg + row * 272 + l15 * 16);
        const int tok = tokbase + row;
        if (tok < M) {
          *(float4*)(e.o32 + (long)tok * e.ld32 + e.c32 + l15 * 4) = o;
        }
      }
    }
    if (e.ob) {
#pragma unroll
      for (int fi = 0; fi < 4; ++fi) {
        float t[4];
#pragma unroll
        for (int j = 0; j < 4; ++j) {
          float u = v[fi][j] * e.post;
          if (e.act == 1) u = silu_f(u); else if (e.act == 2) u = sigm_f(u);
          t[j] = u;
        }
        uint2 o = {pack2(t[0], t[1]), pack2(t[2], t[3])};
        *(uint2*)(reg + l15 * 144 + (fi * 16 + quad * 4) * 2) = o;
      }
#pragma unroll
      for (int i = 0; i < 2; ++i) {
        const int row = i * 8 + (lane >> 3), c8 = lane & 7;
        uint4 o = *(const uint4*)(reg + row * 144 + c8 * 16);
        const int tok = tokbase + row;
        if (tok < M) {
          *(uint4*)(e.ob + (long)tok * e.ldb + e.cb + c8 * 8) = o;
          if (e.ob2) {
            long row2 = (long)(tok >> 4) * SKS + 2048 + (tok & 15);
            *(uint4*)(e.ob2 + row2 * 512 + e.c2 + c8 * 8) = o;
          }
        }
      }
    }
  }
}

DI EpiCfg epi_inproj(const Params& p, int gidx, bool sample) {
  char* ws = p.ws;
  EpiCfg e{};
  e.rs = (const float*)(ws + (sample ? WS_RSTDS : WS_RSTD));
  e.post = 1.f; e.act = 0;
  e.ob = (u16*)(ws + (sample ? WS_ZS : WS_Z)); e.ldb = NZ; e.cb = gidx * 64;
  if (gidx < 8) { e.gain = p.g_qa; e.post = QSCALE; }
  else if (gidx < 16) {
    e.gain = p.g_ka; e.o32 = p.out + (sample ? O_SK : O_PK); e.ld32 = 512; e.c32 = (gidx - 8) * 64;
    if (sample) { e.ob2 = (u16*)(ws + WS_KS); e.c2 = (gidx - 8) * 64; }
  } else if (gidx < 24) {
    e.o32 = p.out + (sample ? O_SV : O_PV); e.ld32 = 512; e.c32 = (gidx - 16) * 64;
    if (sample) { e.ob2 = (u16*)(ws + WS_VS); e.c2 = (gidx - 16) * 64; }
  } else if (gidx < 32) { e.act = 1; }
  else if (gidx < 36) { }
  else if (gidx < 40) { e.post = 0.125f; }
  else if (gidx < 44) { }
  else if (gidx < 48) { e.act = 2; }
  else if (gidx < 52) { e.act = 1; }
  else if (gidx < 56) { e.gain = p.g_qm; e.post = QSCALE; }
  else { e.act = 1; }
  return e;
}


DI void stagger_wait(int slot, int ticks_per_slot) {
  if (threadIdx.x == 0) {
    const long long t0 = wall_clock64();
    const long long dt = (long long)slot * ticks_per_slot;
    while (wall_clock64() - t0 < dt) __builtin_amdgcn_s_sleep(32);
  }
  __syncthreads();
}

DI void phase1(const Params& p, char* smem) {
  char* ws = p.ws;
  constexpr int T_MAIN = 256 * 15, T_MEM = 32 * 2, T_S = 15;
  const bool xmap = gridDim.x == 256;
  for (int t = blockIdx.x; t < T_MAIN + T_MEM + T_S; t += gridDim.x) {
    const u16* A; const u16* W; int M, mt, nt, kind;
    if (t < T_MAIN) {
      kind = 0; mt = t / 15; nt = t % 15;
      if (xmap) { const int x = blockIdx.x & 7, u = (t >> 8) * 32 + (blockIdx.x >> 3); const int r = u % 60; mt = 32 * x + 4 * (u / 60) + (r & 3); nt = r >> 2; }
      A = (const u16*)(ws + WS_XB); W = (const u16*)(ws + WS_WTIN); M = TP;
    }
    else if (t < T_MAIN + T_MEM) { kind = 1; const int u = t - T_MAIN; mt = u / 2; nt = u % 2; A = (const u16*)(ws + WS_MB); W = (const u16*)(ws + WS_WTM); M = TMEM; }
    else { kind = 2; mt = 0; nt = t - T_MAIN - T_MEM; A = (const u16*)(ws + WS_XSB); W = (const u16*)(ws + WS_WTIN); M = TS; }
    float rsv[4];
    load_rs((const float*)(ws + (kind == 0 ? WS_RSTD : (kind == 1 ? WS_RSTDM : WS_RSTDS))), M, mt * 256, rsv);
    f32x4 acc[8][4];
#if PROBE_DUP == 9
    gemm_mainloop(A, M, W, mt * 256, nt * 256, smem, acc, nullptr);
#endif
    gemm_mainloop(A, M, W, mt * 256, nt * 256, smem, acc, nullptr);
    int tid1 = threadIdx.x; asm volatile("" : "+v"(tid1));
    const int wf_ = tid1 >> 8;
    EpiCfg e0, e1;
    if (kind == 1) {
      EpiCfg e{};
      e.rs = (const float*)(ws + WS_RSTDM); e.post = 1.f;
      e.gain = nt == 0 ? p.g_km : nullptr;
      e.o32 = p.out + (nt == 0 ? O_PMK : O_PMV); e.ld32 = 256;
      e.ob = (u16*)(ws + WS_MKV); e.ldb = 512;
      e.c32 = (wf_ * 2) * 64; e.cb = (nt * 4 + wf_ * 2) * 64;
      e0 = e; e.c32 += 64; e.cb += 64; e1 = e;
    } else {
      e0 = epi_inproj(p, nt * 4 + wf_ * 2, kind == 2);
      e1 = epi_inproj(p, nt * 4 + wf_ * 2 + 1, kind == 2);
    }
    stage_gains(e0.gain, e1.gain, smem);
    gemm_epilogue<0>(e0, M, mt * 256, acc, smem, rsv);
    gemm_epilogue<1>(e1, M, mt * 256, acc, smem, rsv);
#if PROBE_DUP == 5
    gemm_epilogue<0>(e0, M, mt * 256, acc, smem, rsv);
    gemm_epilogue<1>(e1, M, mt * 256, acc, smem, rsv);
#endif
    __syncthreads();
  }
  phase1_late(p, smem);
}

DI void phase3(const Params& p, char* smem) {
  char* ws = p.ws;
  constexpr int T_MAIN = 256 * 4, T_S = 4;
  for (int t = blockIdx.x; t < T_MAIN + T_S; t += gridDim.x) {
    const bool smp = t >= T_MAIN;
    int mt = smp ? 0 : t / 4, nt = smp ? t - T_MAIN : t % 4;
    if (!smp && gridDim.x == 256) { const int x = blockIdx.x & 7, u = (t >> 8) * 32 + (blockIdx.x >> 3); mt = 32 * x + (u >> 2); nt = u & 3; }
    const int M = smp ? TS : TP;
    f32x4 acc[8][4];
    gemm_mainloop((const u16*)(ws + (smp ? WS_MIXS : WS_MIX)), M, (const u16*)(ws + WS_WTOUT), mt * 256, nt * 256, smem, acc, (const u16*)(ws + (smp ? WS_XSB : WS_XB)));
    const float rsv[4] = {1.f, 1.f, 1.f, 1.f};
    int tid3 = threadIdx.x; asm volatile("" : "+v"(tid3));
    const int wf_ = tid3 >> 8;
    EpiCfg e{};
    e.post = 1.f; e.ld32 = 1024;
    e.o32 = p.out + (smp ? O_YS : O_Y); e.c32 = nt * 256 + wf_ * 128;
    gemm_epilogue<0>(e, M, mt * 256, acc, smem, rsv);
    e.c32 += 64;
    gemm_epilogue<1>(e, M, mt * 256, acc, smem, rsv);
#if PROBE_DUP == 5
    gemm_epilogue<1>(e, M, mt * 256, acc, smem, rsv);
    e.c32 -= 64;
    gemm_epilogue<0>(e, M, mt * 256, acc, smem, rsv);
#endif
    __syncthreads();
  }
}

struct AttnArgs {
  const u16* Q; long ldq; int nq;
  const u16* K; const u16* V; long ldk; long ldv; int nkeys;
  int ntile_lo, ntile_hi;
  int qpos0; float slope2; float lam;
  const u16* gate; long ldg;
  u16* out; long ldo;
  const float* gsub;
};

struct AttnLocal {
  const u16* Q; long ldq; int nq;
  const u16* K; const u16* V; long ldk; long ldv; int nkeys;
  int ntile_lo, ntile_hi;
  int qpos0; float slope2; float lam;
  const u16* gate; long ldg;
  u16* out; long ldo;
  const float* gsub;
};
template <int NMAP, int DV, bool ALIBI>
DI void attn_item(const u16* aQ, long aldq, int anq, const u16* aK, const u16* aV, long aldk, long aldv, int ankeys,
                  int antile_lo, int antile_hi, int aqpos0, float aslope2, float alam, const u16* agate, long aldg,
                  u16* aout, long aldo, const float* agsub, char* smem) {
  int tid = threadIdx.x; asm volatile("" : "+v"(tid));
  const int lane = tid & 63, w = tid >> 6;
  const int l15 = lane & 15, quad = lane >> 4, l7 = lane & 7;
  constexpr int KMAPB = 16384;
  constexpr int KB = NMAP * KMAPB;
  constexpr int VSTR = DV * 2 + 32;
  constexpr int VB = 128 * VSTR;
  constexpr int STG = KB + VB;
  constexpr int NKC = NMAP * 2;
  constexpr int NVC = DV / 32;
  constexpr int NDT = DV / 16;
  constexpr int VCR = DV / 8;

  bf16x8 qf[NMAP][2];
  {
    int row = w * 16 + l15; row = row < anq ? row : anq - 1;
#pragma unroll
    for (int m = 0; m < NMAP; ++m)
#pragma unroll
      for (int ks = 0; ks < 2; ++ks)
        qf[m][ks] = __builtin_bit_cast(bf16x8, *(const uint4*)(aQ + (long)row * aldq + m * 64 + ks * 32 + quad * 8));
  }
  f32x4 O[NMAP][NDT];
  float mrun[NMAP], lrun[NMAP];
#pragma unroll
  for (int m = 0; m < NMAP; ++m) {
    mrun[m] = -INFINITY; lrun[m] = 0.f;
#pragma unroll
    for (int dt = 0; dt < NDT; ++dt) O[m][dt] = (f32x4){0.f, 0.f, 0.f, 0.f};
  }
  const int npair = (antile_hi + 1) >> 1;
  const int myt = (w < 4) ? antile_lo : antile_hi;
  uint4 rk0, rk1, rk2, rk3, rv0, rv1, rv2, rv3;
  rk0 = (uint4){0u, 0u, 0u, 0u}; rk1 = rk0; rk2 = rk0; rk3 = rk0; rv0 = rk0; rv1 = rk0; rv2 = rk0; rv3 = rk0;
  typedef unsigned u32x4a_t __attribute__((ext_vector_type(4)));
  const __amdgpu_buffer_rsrc_t rsK = __builtin_amdgcn_make_buffer_rsrc((void*)aK, 0, (int)((long)(ankeys - 1) * aldk * 2 + NMAP * 128), 0x00020000);
  const __amdgpu_buffer_rsrc_t rsV = __builtin_amdgcn_make_buffer_rsrc((void*)aV, 0, (int)((long)(ankeys - 1) * aldv * 2 + DV * 2), 0x00020000);
  const int vkoff = (tid / (NMAP * 8)) * (int)aldk * 2 + (tid % (NMAP * 8)) * 16;
  const int vvoff = (tid / VCR) * (int)aldv * 2 + (tid % VCR) * 16;
  const int kstep = (NT / (NMAP * 8)) * (int)aldk * 2, vstep = (NT / VCR) * (int)aldv * 2;
#define ATTN_BL(rs_, vo_, so_, r_) { const u32x4a_t t_ = __builtin_amdgcn_raw_buffer_load_b128(rs_, vo_, so_, 0); r_ = make_uint4(t_[0], t_[1], t_[2], t_[3]); }
#define ATTN_LOADP(p_) do { const int sk_ = (p_) * 128 * (int)aldk * 2, sv_ = (p_) * 128 * (int)aldv * 2; \
    if (NKC > 0) ATTN_BL(rsK, vkoff, sk_, rk0) if (NKC > 1) ATTN_BL(rsK, vkoff, sk_ + kstep, rk1) \
    if (NKC > 2) ATTN_BL(rsK, vkoff, sk_ + 2 * kstep, rk2) if (NKC > 3) ATTN_BL(rsK, vkoff, sk_ + 3 * kstep, rk3) \
    if (NVC > 0) ATTN_BL(rsV, vvoff, sv_, rv0) if (NVC > 1) ATTN_BL(rsV, vvoff, sv_ + vstep, rv1) \
    if (NVC > 2) ATTN_BL(rsV, vvoff, sv_ + 2 * vstep, rv2) if (NVC > 3) ATTN_BL(rsV, vvoff, sv_ + 3 * vstep, rv3) } while (0)
  constexpr int KSTEPB = (NT / (NMAP * 8)) * 128, VSTEPB = (NT / VCR) * VSTR;
#define ATTN_STOREP(stage_) do { char* sb_ = smem + (stage_) * STG; int t2_ = tid; asm volatile("" : "+v"(t2_)); \
    const int kkey0 = t2_ / (NMAP * 8), kcc0 = t2_ % (NMAP * 8); \
    const int ksto = (kcc0 >> 3) * KMAPB + kkey0 * 128 + (((kcc0 & 7) ^ (kkey0 & 7)) * 16); \
    const int vsto = KB + (t2_ / VCR) * VSTR + (t2_ % VCR) * 16; \
    if (NKC > 0) *(uint4*)(sb_ + ksto) = rk0; if (NKC > 1) *(uint4*)(sb_ + ksto + KSTEPB) = rk1; \
    if (NKC > 2) *(uint4*)(sb_ + ksto + 2 * KSTEPB) = rk2; if (NKC > 3) *(uint4*)(sb_ + ksto + 3 * KSTEPB) = rk3; \
    if (NVC > 0) *(uint4*)(sb_ + vsto) = rv0; if (NVC > 1) *(uint4*)(sb_ + vsto + VSTEPB) = rv1; \
    if (NVC > 2) *(uint4*)(sb_ + vsto + 2 * VSTEPB) = rv2; if (NVC > 3) *(uint4*)(sb_ + vsto + 3 * VSTEPB) = rv3; } while (0)
  const int q4 = l15 >> 2, p4 = l15 & 3;
  ATTN_LOADP(0); ATTN_STOREP(0); __syncthreads();
  uint2 pg[NDT];
  const int grow = (w * 16 + l15) < anq ? (w * 16 + l15) : anq - 1;
  for (int pr = 0; pr < npair; ++pr) {
    ATTN_LOADP(pr + 1 < npair ? pr + 1 : pr);
    if (NDT <= 4) {
#pragma unroll
      for (int dt = 0; dt < NDT; ++dt) pg[dt] = *(const uint2*)(agate + (long)grow * aldg + dt * 16 + quad * 4);
    }
    __builtin_amdgcn_sched_barrier(0);
#pragma unroll
    for (int sub = 0; sub < 2; ++sub) {
      const int t = pr * 2 + sub;
      const char* kb = smem + (pr & 1) * STG + sub * 64 * 128; const char* vb = smem + (pr & 1) * STG + KB + sub * 64 * VSTR;
      unsigned pf[NMAP][2][4];
      const bool partial = ((t + 1) * 64 > ankeys) || (t >= myt);
      const int klim = (t >= myt) ? 0 : ankeys;
      f32x4 sall[NMAP][4];
#pragma unroll
      for (int m = 0; m < NMAP; ++m)
#pragma unroll
        for (int kt = 0; kt < 4; ++kt) {
          const char* kr = kb + m * KMAPB + (kt * 16 + l15) * 128;
          f32x4 z = {0.f, 0.f, 0.f, 0.f};
          z = MFMA(ld_frag(kr + ((quad ^ l7) * 16)), qf[m][0], z);
          sall[m][kt] = MFMA(ld_frag(kr + (((4 + quad) ^ l7) * 16)), qf[m][1], z);
        }
      __builtin_amdgcn_sched_barrier(0);
#pragma unroll
      for (int m = 0; m < NMAP; ++m) {
        f32x4 s[4];
#pragma unroll
        for (int kt = 0; kt < 4; ++kt) s[kt] = sall[m][kt];
        float sb = 0.f;
        if (ALIBI) {
          sb = aslope2 * (float)(t * 64 + quad * 4);
          if ((t + 1) * 64 > aqpos0 + w * 16) {
            const float dq = (float)(aqpos0 + w * 16 + l15 - t * 64 - quad * 4);
            const float qoff = aslope2 * (float)(aqpos0 + w * 16 + l15) - sb;
#pragma unroll
            for (int kt = 0; kt < 4; ++kt)
#pragma unroll
              for (int j = 0; j < 4; ++j) s[kt][j] = fmaf(-aslope2, fabsf(dq - (float)(kt * 16 + j)), s[kt][j]) + qoff;
          } else {
#pragma unroll
            for (int kt = 0; kt < 4; ++kt)
#pragma unroll
              for (int j = 0; j < 4; ++j) s[kt][j] = fmaf(aslope2, (float)(kt * 16 + j), s[kt][j]);
          }
        }
        if (partial) {
#pragma unroll
          for (int kt = 0; kt < 4; ++kt)
#pragma unroll
            for (int j = 0; j < 4; ++j) {
              const bool bad = (t * 64 + kt * 16 + quad * 4 + j) >= klim;
              s[kt][j] = bad ? -INFINITY : s[kt][j];
            }
        }
        float mx = -INFINITY;
#pragma unroll
        for (int kt = 0; kt < 4; ++kt)
#pragma unroll
          for (int j = 0; j < 4; ++j) mx = fmaxf(mx, s[kt][j]);
        mx += sb;
        mx = fmaxf(mx, __shfl_xor(mx, 16)); mx = fmaxf(mx, __shfl_xor(mx, 32));
        const float mnew = fmaxf(mrun[m], mx);
        const float alpha = ex2(mrun[m] - mnew);
        mrun[m] = mnew;
        const float eoff = sb - mnew;
        float psum = 0.f;
#pragma unroll
        for (int kt = 0; kt < 4; ++kt)
#pragma unroll
          for (int j = 0; j < 4; ++j) { float pv = ex2(s[kt][j] + eoff); psum += pv; s[kt][j] = pv; }
        lrun[m] = lrun[m] * alpha + psum;
#pragma unroll
        for (int dt = 0; dt < NDT; ++dt) O[m][dt] *= alpha;
#pragma unroll
        for (int ks2 = 0; ks2 < 2; ++ks2) {
          pf[m][ks2][0] = pack2(s[2 * ks2][0], s[2 * ks2][1]);
          pf[m][ks2][1] = pack2(s[2 * ks2][2], s[2 * ks2][3]);
          pf[m][ks2][2] = pack2(s[2 * ks2 + 1][0], s[2 * ks2 + 1][1]);
          pf[m][ks2][3] = pack2(s[2 * ks2 + 1][2], s[2 * ks2 + 1][3]);
        }
      }
      const char* vl = vb + (quad * 4 + q4) * VSTR + p4 * 8;
#pragma unroll
      for (int ks2 = 0; ks2 < 2; ++ks2)
#pragma unroll
        for (int dt = 0; dt < NDT; ++dt) {
          bf16x8 vf = tr_frag(vl + ks2 * 32 * VSTR + dt * 32, 16 * VSTR);
#pragma unroll
          for (int m = 0; m < NMAP; ++m)
            O[m][dt] = MFMA(vf, mk_frag(pf[m][ks2][0], pf[m][ks2][1], pf[m][ks2][2], pf[m][ks2][3]), O[m][dt]);
        }
    }
    ATTN_STOREP((pr + 1) & 1);
    __syncthreads();
  }
  {
    float l0 = lrun[0]; l0 += __shfl_xor(l0, 16); l0 += __shfl_xor(l0, 32);
    const float inv0 = 1.f / l0;
    float inv1 = 0.f;
    if (NMAP == 2) { float l1 = lrun[NMAP - 1]; l1 += __shfl_xor(l1, 16); l1 += __shfl_xor(l1, 32); inv1 = alam / l1; }
    float ss = 0.f;
#pragma unroll
    for (int dt = 0; dt < NDT; ++dt)
#pragma unroll
      for (int j = 0; j < 4; ++j) {
        float o = O[0][dt][j] * inv0;
        if (NMAP == 2) o -= O[NMAP - 1][dt][j] * inv1;
        O[0][dt][j] = o; ss += o * o;
      }
    float r = 1.f;
    if (NMAP == 2) {
      ss += __shfl_xor(ss, 16); ss += __shfl_xor(ss, 32);
      r = rsqrtf(ss * (1.f / DV) + EPS) * 0.8f;
    }
    const int row = w * 16 + l15;
    if (row < anq) {
#pragma unroll
      for (int dt = 0; dt < NDT; ++dt) {
        const int col = dt * 16 + quad * 4;
        const uint2 g = (NDT <= 4) ? pg[dt] : *(const uint2*)(agate + (long)row * aldg + col);
        float g0 = bf_lo(g.x), g1 = bf_hi(g.x), g2 = bf_lo(g.y), g3 = bf_hi(g.y);
        if (NMAP == 2) { float4 gs = *(const float4*)(agsub + col); g0 *= gs.x; g1 *= gs.y; g2 *= gs.z; g3 *= gs.w; }
        uint2 o = {pack2(O[0][dt][0] * r * g0, O[0][dt][1] * r * g1), pack2(O[0][dt][2] * r * g2, O[0][dt][3] * r * g3)};
        *(uint2*)(aout + (long)row * aldo + col) = o;
      }
    }
  }
}

struct MlstmArgs {
  const u16* Z; int nchunk; int nvalid;
  const float* gif;
  int h;
  const float* C0; const float* n0; float m0; bool has_state;
  u16* mix; long ldm;
  const float* g_mh;
  float* oC; float* oN; float* oM;
};

DI void mlstm_item(const u16* aZ, int anchunk, int anvalid, const float* agif, int ah, const float* aC0, const float* an0, float am0,
                   bool ahas_state, u16* amix, long aldm, const float* ag_mh, float* aoC, float* aoN, float* aoM, char* smem) {
  int tid = threadIdx.x; asm volatile("" : "+v"(tid));
  const int lane = tid & 63, w = tid >> 6;
  const int l15 = lane & 15, quad = lane >> 4;
  const int q4 = l15 >> 2, p4 = l15 & 3;
  constexpr int RS = 160;
  constexpr int TB = 64 * RS;
  constexpr int STG = 3 * TB;
  char* ctb = smem + 2 * STG;
  constexpr int CTB = 80 * RS;
  float* ga = (float*)(ctb + 2 * CTB);
  constexpr int GST = 5 * 64 + 4;
  const bool roleB = w >= 4;
  const int wb = w & 3;
  f32x4 Cacc[5];
#pragma unroll
  for (int dt = 0; dt < 5; ++dt) Cacc[dt] = (f32x4){0.f, 0.f, 0.f, 0.f};
  if (ahas_state && roleB) {
#pragma unroll
    for (int dt = 0; dt < 4; ++dt)
#pragma unroll
      for (int j = 0; j < 4; ++j) Cacc[dt][j] = aC0[(16 * wb + quad * 4 + j) * 64 + dt * 16 + l15];
    if (l15 == 0) {
#pragma unroll
      for (int j = 0; j < 4; ++j) Cacc[4][j] = an0[16 * wb + quad * 4 + j];
    }
  }
  float m0 = am0;
  float pig = 0.f, plf = 0.f;
  const bool gvalid = lane < anvalid;
#define MLSTM_GLOAD(c_) do { \
    const float* gp_ = agif + ((long)(c_) * 64 + (gvalid ? lane : 0)) * 8; \
    pig = gvalid ? gp_[ah] : -INFINITY; plf = gvalid ? gp_[4 + ah] : 0.f; \
  } while (0)
#define MLSTM_SCAN(stage_) do { \
    float* g_ = ga + (stage_) * GST; \
    float b_ = plf; \
    _Pragma("unroll") for (int o = 1; o < 64; o <<= 1) { float u_ = __shfl_up(b_, o); if (lane >= o) b_ += u_; } \
    const float av_ = pig - b_; \
    float pm_ = av_; \
    _Pragma("unroll") for (int o = 1; o < 64; o <<= 1) { float u_ = __shfl_up(pm_, o); if (lane >= o) pm_ = fmaxf(pm_, u_); } \
    const float M_ = fmaxf(m0, pm_); \
    const float ML_ = __shfl(M_, 63), bL_ = __shfl(b_, 63); \
    g_[lane] = av_ * LOG2E; g_[64 + lane] = M_ * LOG2E; g_[128 + lane] = expf(-(b_ + M_)); \
    g_[192 + lane] = expf(m0 - M_); g_[256 + lane] = expf(av_ - ML_); \
    if (lane == 0) g_[320] = expf(m0 - ML_); \
    m0 = bL_ + ML_; \
  } while (0)
#define MLSTM_WRITE_CT(buf_) do { char* ct_ = ctb + (buf_) * CTB; \
    _Pragma("unroll") for (int dt = 0; dt < 5; ++dt) { \
      uint2 o_ = {pack2(Cacc[dt][0], Cacc[dt][1]), pack2(Cacc[dt][2], Cacc[dt][3])}; \
      *(uint2*)(ct_ + (dt * 16 + l15) * RS + (16 * wb + quad * 4) * 2) = o_; \
    } } while (0)
  uint4 rq0, rk0, rv0;
  const int ld_row = tid >> 3, ld_cc = tid & 7;
#define MLSTM_LOADC(c_) do { \
    const int rr_ = ld_row < anvalid ? ld_row : anvalid - 1; \
    const u16* b0_ = aZ + ((long)(c_) * 64 + rr_) * NZ + ah * 64 + ld_cc * 8; \
    rq0 = *(const uint4*)(b0_ + 2048); rk0 = *(const uint4*)(b0_ + 2304); rv0 = *(const uint4*)(b0_ + 2560); \
  } while (0)
#define MLSTM_STOREC(stage_) do { \
    char* sb_ = smem + (stage_) * STG + ld_row * RS + ld_cc * 16; \
    *(uint4*)(sb_) = rq0; *(uint4*)(sb_ + TB) = rk0; *(uint4*)(sb_ + 2 * TB) = rv0; \
  } while (0)
  if (roleB) MLSTM_WRITE_CT(0);
  MLSTM_LOADC(0); MLSTM_STOREC(0);
  MLSTM_LOADC(anchunk > 1 ? 1 : 0);
  if (w == 4) { MLSTM_GLOAD(0); MLSTM_SCAN(0); MLSTM_GLOAD(anchunk > 1 ? 1 : 0); }
  __syncthreads();
  const unsigned ones = (l15 == 0) ? 0x3F803F80u : 0u;
  const bf16x8 onesf = mk_frag(ones, ones, ones, ones);
  for (int c = 0; c < anchunk; ++c) {
    const int stage = c & 1;
    MLSTM_STOREC((c + 1) & 1);
    const int cn = c + 2 < anchunk ? c + 2 : anchunk - 1;
    MLSTM_LOADC(cn);
    if (w == 4) {
      if (c + 1 < anchunk) MLSTM_SCAN((c + 1) & 1);
      MLSTM_GLOAD(cn);
    }
    __builtin_amdgcn_sched_barrier(0);
    const char* ct = ctb + stage * CTB;
    const char* sq = smem + stage * STG; const char* sk = sq + TB; const char* sv = sq + 2 * TB;
    const float* g = ga + stage * GST;
    if (!roleB) {
      const int t = 16 * w + l15;
      const float M2t = g[64 + t], emt = g[128 + t], gwt = g[192 + t];
      uint2 pob[4], pgb[4];
      {
        const int tc = t < anvalid ? t : anvalid - 1;
        const u16* zr = aZ + ((long)c * 64 + tc) * NZ + ah * 64 + quad * 4;
#pragma unroll
        for (int dt = 0; dt < 4; ++dt) { pob[dt] = *(const uint2*)(zr + 2816 + dt * 16); pgb[dt] = *(const uint2*)(zr + 3072 + dt * 16); }
      }
      bf16x8 qf0 = ld_frag(sq + t * RS + quad * 16), qf1 = ld_frag(sq + t * RS + (4 + quad) * 16);
      f32x4 pt[4];
#pragma unroll
      for (int st = 0; st < 4; ++st) {
        pt[st] = (f32x4){0.f, 0.f, 0.f, 0.f};
        if (st <= w) {
          const char* kr = sk + (st * 16 + l15) * RS;
          f32x4 z = {0.f, 0.f, 0.f, 0.f};
          z = MFMA(ld_frag(kr + quad * 16), qf0, z);
          z = MFMA(ld_frag(kr + (4 + quad) * 16), qf1, z);
          float4 a2 = *(const float4*)(g + st * 16 + quad * 4);
          const float av[4] = {a2.x, a2.y, a2.z, a2.w};
#pragma unroll
          for (int j = 0; j < 4; ++j) {
            const int sidx = st * 16 + quad * 4 + j;
            const float dw = (sidx <= t) ? ex2(av[j] - M2t) : 0.f;
            pt[st][j] = z[j] * dw;
          }
        }
      }
      bf16x8 pf[2];
#pragma unroll
      for (int ks2 = 0; ks2 < 2; ++ks2)
        pf[ks2] = mk_frag(pack2(pt[2 * ks2][0], pt[2 * ks2][1]), pack2(pt[2 * ks2][2], pt[2 * ks2][3]),
                          pack2(pt[2 * ks2 + 1][0], pt[2 * ks2 + 1][1]), pack2(pt[2 * ks2 + 1][2], pt[2 * ks2 + 1][3]));
      f32x4 H[5];
      const char* vl = sv + (quad * 4 + q4) * RS + p4 * 8;
#pragma unroll
      for (int dt = 0; dt < 5; ++dt) {
        const char* cr = ct + (dt * 16 + l15) * RS;
        f32x4 z = {0.f, 0.f, 0.f, 0.f};
        z = MFMA(ld_frag(cr + quad * 16), qf0, z);
        z = MFMA(ld_frag(cr + (4 + quad) * 16), qf1, z);
        z *= gwt;
#pragma unroll
        for (int ks2 = 0; ks2 < 2; ++ks2) {
          bf16x8 vf = (dt < 4) ? tr_frag(vl + ks2 * 32 * RS + dt * 32, 16 * RS) : onesf;
          z = MFMA(vf, pf[ks2], z);
        }
        H[dt] = z;
      }
      const float den = __shfl(H[4][0], l15);
      const float sc = 1.f / fmaxf(fabsf(den), emt);
      float ss = 0.f;
#pragma unroll
      for (int dt = 0; dt < 4; ++dt)
#pragma unroll
        for (int j = 0; j < 4; ++j) { float hv = H[dt][j] * sc; H[dt][j] = hv; ss += hv * hv; }
      ss += __shfl_xor(ss, 16); ss += __shfl_xor(ss, 32);
      const float r = rsqrtf(ss * (1.f / 64.f) + EPS);
      if (t < anvalid) {
        u16* mr = amix + ((long)c * 64 + t) * aldm + 512 + ah * 64;
#pragma unroll
        for (int dt = 0; dt < 4; ++dt) {
          const int col = dt * 16 + quad * 4;
          const uint2 ob = pob[dt];
          const uint2 gb = pgb[dt];
          float4 gm = *(const float4*)(ag_mh + col);
          float o0 = H[dt][0] * r * gm.x * bf_lo(ob.x) * bf_lo(gb.x);
          float o1 = H[dt][1] * r * gm.y * bf_hi(ob.x) * bf_hi(gb.x);
          float o2 = H[dt][2] * r * gm.z * bf_lo(ob.y) * bf_lo(gb.y);
          float o3 = H[dt][3] * r * gm.w * bf_hi(ob.y) * bf_hi(gb.y);
          uint2 o = {pack2(o0, o1), pack2(o2, o3)};
          *(uint2*)(mr + col) = o;
        }
      }
    } else {
      const float decay = g[320];
#pragma unroll
      for (int dt = 0; dt < 5; ++dt) Cacc[dt] *= decay;
      const char* kl = sk + (quad * 8 + q4) * RS + 16 * wb * 2 + p4 * 8;
      const char* vl2 = sv + (quad * 8 + q4) * RS + p4 * 8;
#pragma unroll
      for (int ks2 = 0; ks2 < 2; ++ks2) {
        uint2 ka = tr_read(kl + ks2 * 32 * RS), kb2 = tr_read(kl + ks2 * 32 * RS + 4 * RS);
        float4 w0 = *(const float4*)(g + 256 + ks2 * 32 + quad * 8), w1 = *(const float4*)(g + 256 + ks2 * 32 + quad * 8 + 4);
        bf16x8 kw = mk_frag(pack2(bf_lo(ka.x) * w0.x, bf_hi(ka.x) * w0.y), pack2(bf_lo(ka.y) * w0.z, bf_hi(ka.y) * w0.w),
                            pack2(bf_lo(kb2.x) * w1.x, bf_hi(kb2.x) * w1.y), pack2(bf_lo(kb2.y) * w1.z, bf_hi(kb2.y) * w1.w));
#pragma unroll
        for (int dt = 0; dt < 5; ++dt) {
          bf16x8 vf = (dt < 4) ? tr_frag(vl2 + ks2 * 32 * RS + dt * 32, 4 * RS) : onesf;
          Cacc[dt] = MFMA(kw, vf, Cacc[dt]);
        }
      }
    }
    if (roleB) MLSTM_WRITE_CT((c + 1) & 1);
    __syncthreads();
  }
  if (roleB) {
#pragma unroll
    for (int dt = 0; dt < 4; ++dt)
#pragma unroll
      for (int j = 0; j < 4; ++j) aoC[(16 * wb + quad * 4 + j) * 64 + dt * 16 + l15] = Cacc[dt][j];
    if (l15 == 0) {
#pragma unroll
      for (int j = 0; j < 4; ++j) aoN[16 * wb + quad * 4 + j] = Cacc[4][j];
    }
    if (tid == 256) *aoM = m0;
  }
}

DI int next_item(int* counter, int* s_item) {
  __syncthreads();
  if (threadIdx.x == 0) *s_item = atomicAdd(counter, 1);
  __syncthreads();
  return __builtin_amdgcn_readfirstlane(*s_item);
}

DI void phase2(const Params& p, char* smem, int cbase) {
  char* ws = p.ws;
  int* s_item = (int*)(smem + LDS_BYTES - 16);
  int* counters = (int*)(ws + WS_CTL) + cbase;
  const u16* Z = (const u16*)(ws + WS_Z); const u16* ZS = (const u16*)(ws + WS_ZS);
  u16* MIX = (u16*)(ws + WS_MIX); u16* MIXS = (u16*)(ws + WS_MIXS);
  for (int rep = 0; rep < (PROBE_DUP == 6 ? 2 : 1); ++rep)
  while (true) {
    const int it = next_item(counters + 4 + rep * 16, s_item);
    if (it >= 160) break;
    if (it < 128) {
      const int b = it >> 2, h = it & 3;
      mlstm_item(Z + (long)b * 2048 * NZ, 32, 64, (const float*)(ws + WS_GIF) + (long)b * 2048 * 8, h, p.sC, p.sN, 0.f, false,
                 MIX + (long)b * 2048 * 1024, 1024, p.g_mh, p.out + O_PC + (long)(b * 4 + h) * 4096, p.out + O_PN + (b * 4 + h) * 64,
                 p.out + O_PM + b * 4 + h, smem);
    } else {
      const int u = it - 128; const int b = u >> 2, h = u & 3;
      mlstm_item(ZS + (long)b * 16 * NZ, 1, 16, (const float*)(ws + WS_GIFS) + (long)b * 16 * 8, h, p.sC + (long)(b * 4 + h) * 4096,
                 p.sN + (b * 4 + h) * 64, p.sM[b * 4 + h], true, MIXS + (long)b * 16 * 1024, 1024, p.g_mh,
                 p.out + O_SC + (long)(b * 4 + h) * 4096, p.out + O_SN + (b * 4 + h) * 64, p.out + O_SM + b * 4 + h, smem);
    }
  }
  {
    const float lam = ((const float*)(ws + WS_CTL))[1];
    for (int pass = 0; pass < 8; ++pass)
    while (true) {
      const int xq = ((int)(blockIdx.x & 7) + pass) & 7;
      const int iq = next_item(counters + 40 + xq, s_item);
      if (iq >= 4 + 256) break;
      const int it = iq < 4 ? xq * 4 + iq : 32 + xq * 256 + (iq - 4);
      const u16 *aQ, *aK, *aV, *agate; u16* aout; long ldq, ldk; int nq, nkeys, tlo, thi, qpos0, h;
      if (it < 32) {
        const int b = it >> 2; h = it & 3;
        aQ = ZS + (long)b * 16 * NZ + h * 128; ldq = NZ; nq = 16;
        aK = (const u16*)(ws + WS_KS) + (long)b * SKS * 512 + h * 128; aV = (const u16*)(ws + WS_VS) + (long)b * SKS * 512 + h * 128;
        ldk = 512; nkeys = SKS; tlo = 33; thi = 33; qpos0 = 2048;
        agate = ZS + (long)b * 16 * NZ + 1536 + h * 128; aout = MIXS + (long)b * 16 * 1024 + h * 128;
      } else {
        const int u = it - 32; const int grp = u >> 8, rr = u & 255; const int qb = 15 - (rr >> 4); const int bh = grp * 16 + (rr & 15); const int b = bh >> 2; h = bh & 3;
        const long tok0 = (long)b * 2048 + qb * 128;
        aQ = Z + tok0 * NZ + h * 128; ldq = NZ; nq = 128;
        aK = Z + (long)b * 2048 * NZ + 512 + h * 128; aV = Z + (long)b * 2048 * NZ + 1024 + h * 128;
        ldk = NZ; nkeys = 2048; tlo = 2 * qb + 1; thi = 2 * qb + 2; qpos0 = qb * 128;
        agate = Z + tok0 * NZ + 1536 + h * 128; aout = MIX + tok0 * 1024 + h * 128;
      }
      attn_item<2, 128, true>(aQ, ldq, nq, aK, aV, ldk, ldk, nkeys, tlo, thi, qpos0, exp2f(-2.f * (h + 1)) * LOG2E, lam, agate, NZ,
                              aout, 1024, p.g_subln, smem);
    }
  }
  for (int rep = 0; rep < (PROBE_DUP == 8 ? 2 : 1); ++rep)
  while (true) {
    const int it = next_item(counters + 12 + rep * 16, s_item);
    if (it >= 2048 + 32) break;
    const u16 *aQ, *aK, *agate; u16* aout; int nq;
    if (it < 2048) {
      const int tb = it >> 2, h = it & 3; const int b = tb >> 4;
      const long tok0 = (long)tb * 128;
      aQ = Z + tok0 * NZ + 3328 + h * 64; nq = 128;
      aK = (const u16*)(ws + WS_MKV) + (long)b * 256 * 512 + h * 64;
      agate = Z + tok0 * NZ + 3584 + h * 64; aout = MIX + tok0 * 1024 + 768 + h * 64;
    } else {
      const int u = it - 2048; const int b = u >> 2, h = u & 3;
      aQ = ZS + (long)b * 16 * NZ + 3328 + h * 64; nq = 16;
      aK = (const u16*)(ws + WS_MKVS) + (long)b * 256 * 512 + h * 64;
      agate = ZS + (long)b * 16 * NZ + 3584 + h * 64; aout = MIXS + (long)b * 16 * 1024 + 768 + h * 64;
    }
    attn_item<1, 64, false>(aQ, NZ, nq, aK, aK + 256, 512, 512, 256, 4, 4, 0, 0.f, 0.f, agate, NZ, aout, 1024, p.g_subln, smem);
  }
}


DI void grid_barrier(unsigned* ctr, unsigned target) {
  __syncthreads();
  if (threadIdx.x == 0) {
    __builtin_amdgcn_fence(__ATOMIC_RELEASE, "agent");
    asm volatile("s_waitcnt vmcnt(0)" ::: "memory");
    __hip_atomic_fetch_add(ctr, 1u, __ATOMIC_RELAXED, __HIP_MEMORY_SCOPE_AGENT);
    while (__hip_atomic_load(ctr, __ATOMIC_RELAXED, __HIP_MEMORY_SCOPE_AGENT) < target) __builtin_amdgcn_s_sleep(2);
    __builtin_amdgcn_fence(__ATOMIC_ACQUIRE, "agent");
    asm volatile("s_waitcnt vmcnt(0)" ::: "memory");
  }
  __syncthreads();
}

__global__ void __launch_bounds__(512) fwd_megakernel(Params p, int phase_lo, int phase_hi, int coop) {
  extern __shared__ __attribute__((aligned(16))) char smem[];
  cg::grid_group grid = cg::this_grid();
  if (phase_lo <= 0 && phase_hi > 0) phase0(p, smem);
#if PROBE_DUP == 4
  __syncthreads();
  if (phase_lo <= 0 && phase_hi > 0) phase0(p, smem);
#endif
  if (coop) grid.sync();
  if (phase_lo <= 1 && phase_hi > 1) phase1(p, smem);
#if PROBE_DUP == 1
  if (phase_lo <= 1 && phase_hi > 1) phase1(p, smem);
#endif
  unsigned* gctr = (unsigned*)(p.ws + WS_CTL) + 32;
  if (coop) grid_barrier(gctr, gridDim.x);
  if (phase_lo <= 2 && phase_hi > 2) phase2(p, smem, 0);
#if PROBE_DUP == 2
  if (phase_lo <= 2 && phase_hi > 2) phase2(p, smem, 16);
#endif
  if (coop) grid_barrier(gctr, 2u * gridDim.x);
  if (phase_lo <= 3 && phase_hi > 3) phase3(p, smem);
#if PROBE_DUP == 3
  if (phase_lo <= 3 && phase_hi > 3) phase3(p, smem);
#endif
}

extern "C" void kernel_launch(void* const* d_in, const int* in_sizes, int n_in, void* d_out, int out_size,
                              void* d_ws, size_t ws_size, hipStream_t stream) {
  static int grid_blocks = 0;
  if (!grid_blocks) {
    int dev = 0, cus = 0, per_cu = 0;
    (void)hipGetDevice(&dev);
    (void)hipDeviceGetAttribute(&cus, hipDeviceAttributeMultiprocessorCount, dev);
    (void)hipFuncSetAttribute((const void*)fwd_megakernel, hipFuncAttributeMaxDynamicSharedMemorySize, LDS_BYTES);
    (void)hipOccupancyMaxActiveBlocksPerMultiprocessor(&per_cu, fwd_megakernel, 512, LDS_BYTES);
    if (per_cu < 1) per_cu = 1;
    if (per_cu > 1) per_cu = 1;
    grid_blocks = cus * per_cu;
    if (ws_size < WS_END) fprintf(stderr, "workspace too small: %zu < %zu\n", ws_size, (size_t)WS_END);
  }
  Params p{};
  const float** pp = (const float**)&p;
  for (int i = 0; i < 28; ++i) pp[i] = (const float*)d_in[i];
  p.out = (float*)d_out; p.ws = (char*)d_ws;
  int lo = 0, hi = 4, coop = 1;
  void* args[] = {&p, &lo, &hi, &coop};
  hipError_t e = hipLaunchCooperativeKernel((void*)fwd_megakernel, dim3(grid_blocks), dim3(512), args, LDS_BYTES, stream);
  if (e != hipSuccess) fprintf(stderr, "cooperative launch failed: %s (grid %d)\n", hipGetErrorString(e), grid_blocks);
}
```

```cpp
#include <hip/hip_runtime.h>
#include <hip/hip_cooperative_groups.h>
#include <cstdio>
namespace cg = cooperative_groups;

typedef unsigned short u16;
typedef short bf16x8 __attribute__((ext_vector_type(8)));
typedef short s16x4 __attribute__((ext_vector_type(4)));
typedef float f32x4 __attribute__((ext_vector_type(4)));
typedef float f32x2 __attribute__((ext_vector_type(2)));
typedef __bf16 bf16x2_t __attribute__((ext_vector_type(2)));
#define DI __device__ __forceinline__
#define MFMA(a, b, c) __builtin_amdgcn_mfma_f32_16x16x32_bf16((a), (b), (c), 0, 0, 0)

constexpr int DM = 1024;
constexpr int TP = 65536;
constexpr int TS = 128;
constexpr int TMEM = 8192;
constexpr int NZ = 3840;
constexpr int NIN = 3848;
constexpr int SKS = 2064;
constexpr float EPS = 1e-6f;
constexpr float LOG2E = 1.4426950408889634f;
constexpr float QSCALE = 0.125f * LOG2E;

constexpr size_t WS_CTL = 0;
constexpr size_t WS_WTIN = 4096;
constexpr size_t WS_WTOUT = WS_WTIN + (size_t)NZ * 1024 * 2;
constexpr size_t WS_WTM = WS_WTOUT + (size_t)1024 * 1024 * 2;
constexpr size_t WS_XB = WS_WTM + (size_t)512 * 1024 * 2;
constexpr size_t WS_XSB = WS_XB + (size_t)TP * 1024 * 2;
constexpr size_t WS_MB = WS_XSB + (size_t)TS * 1024 * 2;
constexpr size_t WS_RSTD = WS_MB + (size_t)TMEM * 1024 * 2;
constexpr size_t WS_RSTDS = WS_RSTD + (size_t)TP * 4;
constexpr size_t WS_RSTDM = WS_RSTDS + (size_t)TS * 4;
constexpr size_t WS_GIF = WS_RSTDM + (size_t)TMEM * 4;
constexpr size_t WS_GIFS = WS_GIF + (size_t)TP * 8 * 4;
constexpr size_t WS_Z = WS_GIFS + (size_t)TS * 8 * 4;
constexpr size_t WS_ZS = WS_Z + (size_t)TP * NZ * 2;
constexpr size_t WS_MIX = WS_ZS + (size_t)TS * NZ * 2;
constexpr size_t WS_MIXS = WS_MIX + (size_t)TP * 1024 * 2;
constexpr size_t WS_KS = WS_MIXS + (size_t)TS * 1024 * 2;
constexpr size_t WS_VS = WS_KS + (size_t)8 * SKS * 512 * 2;
constexpr size_t WS_MKV = WS_VS + (size_t)8 * SKS * 512 * 2;
constexpr size_t WS_MKVS = WS_MKV + (size_t)TMEM * 512 * 2;
constexpr size_t WS_END = WS_MKVS + (size_t)2048 * 512 * 2;

constexpr long O_Y = 0;
constexpr long O_YS = O_Y + 67108864L;
constexpr long O_PK = O_YS + 131072L;
constexpr long O_PV = O_PK + 33554432L;
constexpr long O_PC = O_PV + 33554432L;
constexpr long O_PN = O_PC + 524288L;
constexpr long O_PM = O_PN + 8192L;
constexpr long O_PMK = O_PM + 128L;
constexpr long O_PMV = O_PMK + 2097152L;
constexpr long O_SK = O_PMV + 2097152L;
constexpr long O_SV = O_SK + 65536L;
constexpr long O_SC = O_SV + 65536L;
constexpr long O_SN = O_SC + 131072L;
constexpr long O_SM = O_SN + 2048L;

constexpr int LDS_BYTES = 143360;
constexpr int NT = 512;
constexpr int NWV = 8;
#ifndef STAG1
#define STAG1 350
#endif
#ifndef STAG3
#define STAG3 450
#endif
#ifndef PROBE_DUP
#define PROBE_DUP 0
#endif

struct Params {
  const float* x; const float* xs; const float* ck; const float* cv; const float* sC; const float* sN; const float* sM;
  const float* cmk; const float* cmv; const float* mem; const float* g_norm; const float* w_in; const float* w_out;
  const float* g_qa; const float* g_ka; const float* lq1; const float* lk1; const float* lq2; const float* lk2;
  const float* g_subln; const float* b_i; const float* b_f; const float* g_mh; const float* g_qm; const float* g_km;
  const float* g_mem; const float* w_mk; const float* w_mv;
  float* out; char* ws;
};

DI unsigned pack2(float a, float b) { f32x2 v = {a, b}; return __builtin_bit_cast(unsigned, __builtin_convertvector(v, bf16x2_t)); }
DI float bf_lo(unsigned u) { return __uint_as_float(u << 16); }
DI float bf_hi(unsigned u) { return __uint_as_float(u & 0xffff0000u); }
DI float ex2(float x) { return __builtin_amdgcn_exp2f(x); }
DI bf16x8 ld_frag(const char* p) { return __builtin_bit_cast(bf16x8, *(const uint4*)p); }
DI bf16x8 mk_frag(unsigned a, unsigned b, unsigned c, unsigned d) { uint4 v = {a, b, c, d}; return __builtin_bit_cast(bf16x8, v); }
DI uint2 tr_read(const char* p) {
  s16x4 r = __builtin_amdgcn_ds_read_tr16_b64_v4i16((__attribute__((address_space(3))) s16x4*)(p));
  return __builtin_bit_cast(uint2, r);
}
DI bf16x8 tr_frag(const char* p, int off2) { uint2 a = tr_read(p), b = tr_read(p + off2); return mk_frag(a.x, a.y, b.x, b.y); }
DI float wave_sum(float v) {
#pragma unroll
  for (int o = 32; o > 0; o >>= 1) v += __shfl_xor(v, o);
  return v;
}
DI float silu_f(float x) { return x * __builtin_amdgcn_rcpf(1.f + __expf(-x)); }
DI float sigm_f(float x) { return __builtin_amdgcn_rcpf(1.f + __expf(-x)); }

DI void phase0(const Params& p, char* smem) {
  const int tid = threadIdx.x, lane = tid & 63, wave = tid >> 6;
  char* ws = p.ws;
  if (blockIdx.x == 0 && wave == 0) {
    float a = wave_sum(p.lq1[lane] * p.lk1[lane]);
    float b = wave_sum(p.lq2[lane] * p.lk2[lane]);
    if (lane == 0) {
      ((int*)(ws + WS_CTL))[4] = 0; ((int*)(ws + WS_CTL))[8] = 0; ((int*)(ws + WS_CTL))[12] = 0;
      ((int*)(ws + WS_CTL))[32] = 0; ((int*)(ws + WS_CTL))[36] = 0;
      for (int q = 40; q < 48; ++q) ((int*)(ws + WS_CTL))[q] = 0;
      ((int*)(ws + WS_CTL))[20] = 0; ((int*)(ws + WS_CTL))[24] = 0; ((int*)(ws + WS_CTL))[28] = 0;
      ((float*)(ws + WS_CTL))[1] = expf(a) - expf(b) + 0.2f;
    }
  }
  float* WG = (float*)smem;
  for (int k = tid; k < 1024; k += NT) {
    float g = p.g_norm[k];
    float4 a = *(const float4*)(p.w_in + (long)k * NIN + 3072);
    float4 b = *(const float4*)(p.w_in + (long)k * NIN + 3076);
    float4 a2 = {a.x * g, a.y * g, a.z * g, a.w * g}, b2 = {b.x * g, b.y * g, b.z * g, b.w * g};
    *(float4*)(WG + k * 8) = a2; *(float4*)(WG + k * 8 + 4) = b2;
  }
  __syncthreads();
  {
    constexpr int RPW = 4;
    const int gw = blockIdx.x * NWV + wave, nw = gridDim.x * NWV;
    constexpr int NROWS = TP + TS + TMEM;
    for (int r0 = gw; r0 < NROWS; r0 += RPW * nw) {
      const float* src[RPW]; u16* dst[RPW]; float* rsp[RPW]; float* gif[RPW]; bool live[RPW];
#pragma unroll
      for (int q = 0; q < RPW; ++q) {
        int r = r0 + q * nw; live[q] = r < NROWS; r = live[q] ? r : r0;
        if (r < TP) { src[q] = p.x + (long)r * 1024; dst[q] = (u16*)(ws + WS_XB) + (long)r * 1024; rsp[q] = (float*)(ws + WS_RSTD) + r; gif[q] = (float*)(ws + WS_GIF) + (long)r * 8; }
        else if (r < TP + TS) { int u = r - TP; src[q] = p.xs + (long)u * 1024; dst[q] = (u16*)(ws + WS_XSB) + (long)u * 1024; rsp[q] = (float*)(ws + WS_RSTDS) + u; gif[q] = (float*)(ws + WS_GIFS) + (long)u * 8; }
        else { int u = r - TP - TS; src[q] = p.mem + (long)u * 1024; dst[q] = (u16*)(ws + WS_MB) + (long)u * 1024; rsp[q] = (float*)(ws + WS_RSTDM) + u; gif[q] = nullptr; }
      }
      float4 vv[RPW][4];
#pragma unroll
      for (int q = 0; q < RPW; ++q)
#pragma unroll
        for (int i = 0; i < 4; ++i) { const f32x4 t_ = __builtin_nontemporal_load((const f32x4*)(src[q] + (i >> 1) * 512 + lane * 8 + (i & 1) * 4)); vv[q][i] = make_float4(t_[0], t_[1], t_[2], t_[3]); }
      float ss[RPW];
#pragma unroll
      for (int q = 0; q < RPW; ++q) {
        ss[q] = 0.f;
#pragma unroll
        for (int i = 0; i < 4; ++i) ss[q] += vv[q][i].x * vv[q][i].x + vv[q][i].y * vv[q][i].y + vv[q][i].z * vv[q][i].z + vv[q][i].w * vv[q][i].w;
      }
#pragma unroll
      for (int o = 32; o > 0; o >>= 1)
#pragma unroll
        for (int q = 0; q < RPW; ++q) ss[q] += __shfl_xor(ss[q], o);
      float rstd[RPW];
#pragma unroll
      for (int q = 0; q < RPW; ++q) {
        rstd[q] = rsqrtf(ss[q] * (1.f / 1024.f) + EPS);
        if (live[q]) {
#pragma unroll
          for (int hh = 0; hh < 2; ++hh) { uint4 o_ = {pack2(vv[q][2 * hh].x, vv[q][2 * hh].y), pack2(vv[q][2 * hh].z, vv[q][2 * hh].w), pack2(vv[q][2 * hh + 1].x, vv[q][2 * hh + 1].y), pack2(vv[q][2 * hh + 1].z, vv[q][2 * hh + 1].w)}; *(uint4*)(dst[q] + hh * 512 + lane * 8) = o_; }
          if (lane == 0) *rsp[q] = rstd[q];
        }
      }
      if (gif[0] || gif[RPW - 1]) {
        float g[RPW][8];
#pragma unroll
        for (int q = 0; q < RPW; ++q)
#pragma unroll
          for (int j = 0; j < 8; ++j) g[q][j] = 0.f;
#pragma unroll
        for (int i = 0; i < 4; ++i)
#pragma unroll
          for (int e = 0; e < 4; ++e) {
            const float* wr = WG + ((i >> 1) * 512 + lane * 8 + (i & 1) * 4 + e) * 8;
            const float4 wa = *(const float4*)wr, wb = *(const float4*)(wr + 4);
#pragma unroll
            for (int q = 0; q < RPW; ++q) {
              const float xv = e == 0 ? vv[q][i].x : (e == 1 ? vv[q][i].y : (e == 2 ? vv[q][i].z : vv[q][i].w));
              g[q][0] += xv * wa.x; g[q][1] += xv * wa.y; g[q][2] += xv * wa.z; g[q][3] += xv * wa.w;
              g[q][4] += xv * wb.x; g[q][5] += xv * wb.y; g[q][6] += xv * wb.z; g[q][7] += xv * wb.w;
            }
          }
        const bool hi = (lane & 32) != 0, h2 = (lane & 16) != 0, h3 = (lane & 8) != 0;
        float c0[RPW];
#pragma unroll
        for (int q = 0; q < RPW; ++q) {
          float a0 = hi ? g[q][4] : g[q][0], a1 = hi ? g[q][5] : g[q][1], a2 = hi ? g[q][6] : g[q][2], a3 = hi ? g[q][7] : g[q][3];
          const float s0 = hi ? g[q][0] : g[q][4], s1 = hi ? g[q][1] : g[q][5], s2 = hi ? g[q][2] : g[q][6], s3 = hi ? g[q][3] : g[q][7];
          a0 += __shfl_xor(s0, 32); a1 += __shfl_xor(s1, 32); a2 += __shfl_xor(s2, 32); a3 += __shfl_xor(s3, 32);
          float b0 = h2 ? a2 : a0, b1 = h2 ? a3 : a1;
          const float t0 = h2 ? a0 : a2, t1 = h2 ? a1 : a3;
          b0 += __shfl_xor(t0, 16); b1 += __shfl_xor(t1, 16);
          float c = h3 ? b1 : b0; const float u0 = h3 ? b0 : b1;
          c += __shfl_xor(u0, 8);
          c0[q] = c;
        }
#pragma unroll
        for (int o = 4; o > 0; o >>= 1)
#pragma unroll
          for (int q = 0; q < RPW; ++q) c0[q] += __shfl_xor(c0[q], o);
        const int jg = 4 * (lane >> 5) + 2 * ((lane >> 4) & 1) + ((lane >> 3) & 1);
        const float bias = jg < 4 ? p.b_i[jg] : p.b_f[jg - 4];
#pragma unroll
        for (int q = 0; q < RPW; ++q) {
          if (live[q] && gif[q] && (lane & 7) == 0) {
            const float xx = c0[q] * rstd[q] + bias;
            gif[q][jg] = jg < 4 ? xx : fminf(xx, 0.f) - log1pf(expf(-fabsf(xx)));
          }
        }
      }
    }
  }
  const long gtid = (long)blockIdx.x * NT + tid, nth = (long)gridDim.x * NT;
  {
    u16* wt = (u16*)(ws + WS_WTIN);
    for (long idx = gtid; idx < (long)NZ * 128; idx += nth) {
      int n = (int)(idx % NZ), kc = (int)(idx / NZ);
      int on = n < 3072 ? n : n + 8;
      float v[8];
#pragma unroll
      for (int e = 0; e < 8; ++e) v[e] = p.w_in[(long)(kc * 8 + e) * NIN + on] * p.g_norm[kc * 8 + e];
      uint4 o = {pack2(v[0], v[1]), pack2(v[2], v[3]), pack2(v[4], v[5]), pack2(v[6], v[7])};
      *(uint4*)(wt + (long)n * 1024 + kc * 8) = o;
    }
    u16* wm = (u16*)(ws + WS_WTM);
    for (long idx = gtid; idx < 512L * 128; idx += nth) {
      int n = (int)(idx % 512), kc = (int)(idx / 512);
      const float* src = n < 256 ? p.w_mk + n : p.w_mv + (n - 256);
      float v[8];
#pragma unroll
      for (int e = 0; e < 8; ++e) v[e] = src[(long)(kc * 8 + e) * 256] * p.g_mem[kc * 8 + e];
      uint4 o = {pack2(v[0], v[1]), pack2(v[2], v[3]), pack2(v[4], v[5]), pack2(v[6], v[7])};
      *(uint4*)(wm + (long)n * 1024 + kc * 8) = o;
    }
  }
}

DI void phase1_late(const Params& p, char* smem) {
  const int tid = threadIdx.x;
  char* ws = p.ws;
  int* s_item = (int*)(smem + LDS_BYTES - 16);
  int* counter = (int*)(ws + WS_CTL) + 36;
  constexpr long N_WO = 1024L * 128, N_KV = 2L * 8 * 2048 * 64, N_MK = 2L * 2048 * 32;
  constexpr int CH = 8192;
  constexpr int NCH = (int)((N_WO + N_KV + N_MK + CH - 1) / CH);
  u16* wo = (u16*)(ws + WS_WTOUT);
  u16* ks = (u16*)(ws + WS_KS); u16* vs = (u16*)(ws + WS_VS);
  u16* mk = (u16*)(ws + WS_MKVS);
  while (true) {
    __syncthreads();
    if (tid == 0) *s_item = atomicAdd(counter, 1);
    __syncthreads();
    const int ch = __builtin_amdgcn_readfirstlane(*s_item);
    if (ch >= NCH) break;
#pragma unroll 4
    for (int i = 0; i < CH / NT; ++i) {
      long idx = (long)ch * CH + i * NT + tid;
      if (idx < N_WO) {
        int n = (int)(idx % 1024), kc = (int)(idx / 1024);
        float v[8];
#pragma unroll
        for (int e = 0; e < 8; ++e) v[e] = p.w_out[(long)(kc * 8 + e) * 1024 + n];
        uint4 o = {pack2(v[0], v[1]), pack2(v[2], v[3]), pack2(v[4], v[5]), pack2(v[6], v[7])};
        *(uint4*)(wo + (long)n * 1024 + kc * 8) = o;
      } else if (idx < N_WO + N_KV) {
        long id = idx - N_WO; const float* srcb = p.ck; u16* dstb = ks;
        if (id >= 8L * 2048 * 64) { id -= 8L * 2048 * 64; srcb = p.cv; dstb = vs; }
        int c = (int)(id & 63); long row = id >> 6; int b = (int)(row >> 11); int rr = (int)(row & 2047);
        const float* sp = srcb + row * 512 + c * 8;
        float4 a = *(const float4*)sp, bb = *(const float4*)(sp + 4);
        uint4 o = {pack2(a.x, a.y), pack2(a.z, a.w), pack2(bb.x, bb.y), pack2(bb.z, bb.w)};
        *(uint4*)(dstb + ((long)b * SKS + rr) * 512 + c * 8) = o;
      } else if (idx < N_WO + N_KV + N_MK) {
        long id = idx - N_WO - N_KV; const float* srcb = p.cmk; int coff = 0;
        if (id >= 2048L * 32) { id -= 2048L * 32; srcb = p.cmv; coff = 256; }
        int c = (int)(id & 31); long row = id >> 5;
        const float* sp = srcb + row * 256 + c * 8;
        float4 a = *(const float4*)sp, bb = *(const float4*)(sp + 4);
        uint4 o = {pack2(a.x, a.y), pack2(a.z, a.w), pack2(bb.x, bb.y), pack2(bb.z, bb.w)};
        *(uint4*)(mk + row * 512 + coff + c * 8) = o;
      }
    }
  }
}

struct EpiCfg {
  const float* rs; const float* gain; float post; int act;
  float* o32; long ld32; int c32;
  u16* ob; long ldb; int cb;
  u16* ob2; int c2;
  const float* resid;
};

DI void gemm_mainloop(const u16* __restrict__ A, int M, const u16* __restrict__ W, int m0, int n0, char* smem, f32x4 (&acc)[8][4], const u16* resid) {
  int tid = threadIdx.x; asm volatile("" : "+v"(tid));
  const int lane = tid & 63, wave = tid >> 6;
  const int l15 = lane & 15, quad = lane >> 4, l7 = lane & 7;
  const int wt = wave & 3, wf_ = wave >> 2;
  const int c8 = tid & 7, r0 = tid >> 3;
  if (resid) {
#pragma unroll
    for (int b = 0; b < 4; ++b) {
      int tok = m0 + wt * 64 + b * 16 + l15; tok = tok < M ? tok : M - 1;
      const u16* xr = resid + (long)tok * 1024 + n0 + wf_ * 128 + quad * 4;
#pragma unroll
      for (int a = 0; a < 8; ++a) { uint2 x2 = *(const uint2*)(xr + a * 16); acc[a][b] = (f32x4){bf_lo(x2.x), bf_hi(x2.x), bf_lo(x2.y), bf_hi(x2.y)}; }
    }
  } else {
#pragma unroll
    for (int a = 0; a < 8; ++a)
#pragma unroll
      for (int b = 0; b < 4; ++b) acc[a][b] = (f32x4){0.f, 0.f, 0.f, 0.f};
  }
  uint4 ra0, ra1, ra2, ra3, rw0, rw1, rw2, rw3;
  const int st_off = r0 * 128 + ((c8 ^ (r0 & 7)) * 16);
  int ar0 = m0 + r0, ar1 = m0 + r0 + 64, ar2 = m0 + r0 + 128, ar3 = m0 + r0 + 192;
  ar0 = ar0 < M ? ar0 : M - 1; ar1 = ar1 < M ? ar1 : M - 1; ar2 = ar2 < M ? ar2 : M - 1; ar3 = ar3 < M ? ar3 : M - 1;
  const u16* pa0 = A + (long)ar0 * 1024 + c8 * 8; const u16* pa1 = A + (long)ar1 * 1024 + c8 * 8;
  const u16* pa2 = A + (long)ar2 * 1024 + c8 * 8; const u16* pa3 = A + (long)ar3 * 1024 + c8 * 8;
  const u16* pw0 = W + (long)(n0 + r0) * 1024 + c8 * 8;
#define GEMM_LOADK(kt_) do { const int ko_ = (kt_) * 64; \
    ra0 = *(const uint4*)(pa0 + ko_); ra1 = *(const uint4*)(pa1 + ko_); ra2 = *(const uint4*)(pa2 + ko_); ra3 = *(const uint4*)(pa3 + ko_); \
    rw0 = *(const uint4*)(pw0 + ko_); rw1 = *(const uint4*)(pw0 + 65536 + ko_); rw2 = *(const uint4*)(pw0 + 131072 + ko_); rw3 = *(const uint4*)(pw0 + 196608 + ko_); \
  } while (0)
#define GEMM_STOREK(stage_) do { char* sa_ = smem + (stage_) * 65536 + st_off; char* sw_ = sa_ + 32768; \
    *(uint4*)(sa_) = ra0; *(uint4*)(sa_ + 8192) = ra1; *(uint4*)(sa_ + 16384) = ra2; *(uint4*)(sa_ + 24576) = ra3; \
    *(uint4*)(sw_) = rw0; *(uint4*)(sw_ + 8192) = rw1; *(uint4*)(sw_ + 16384) = rw2; *(uint4*)(sw_ + 24576) = rw3; \
  } while (0)
  GEMM_LOADK(0); GEMM_STOREK(0); __syncthreads();
  for (int kt = 0; kt < 16; ++kt) {
    GEMM_LOADK(kt + 1 < 16 ? kt + 1 : kt);
    __builtin_amdgcn_sched_barrier(0);
    const char* sa = smem + (kt & 1) * 65536; const char* sw = sa + 32768;
#pragma unroll
    for (int ks = 0; ks < 2; ++ks) {
      const int sw_off = ((ks * 4 + quad) ^ l7) * 16;
      bf16x8 wfr[8];
#pragma unroll
      for (int fi = 0; fi < 8; ++fi) wfr[fi] = ld_frag(sw + (wf_ * 128 + fi * 16 + l15) * 128 + sw_off);
#pragma unroll
      for (int ti = 0; ti < 4; ++ti) {
        const bf16x8 tf = ld_frag(sa + (wt * 64 + ti * 16 + l15) * 128 + sw_off);
#pragma unroll
        for (int fi = 0; fi < 8; ++fi) acc[fi][ti] = MFMA(wfr[fi], tf, acc[fi][ti]);
      }
    }
    GEMM_STOREK((kt + 1) & 1);
    __syncthreads();
  }
}

DI void load_rs(const float* rsp, int M, int m0, float (&rsv)[4]) {
  int tid = threadIdx.x; asm volatile("" : "+v"(tid));
  const int lane = tid & 63, wave = tid >> 6;
  const int l15 = lane & 15, wt = wave & 3;
#pragma unroll
  for (int ti = 0; ti < 4; ++ti) {
    const int tok = m0 + wt * 64 + ti * 16 + l15;
    rsv[ti] = rsp ? rsp[tok < M ? tok : M - 1] : 1.f;
  }
}

DI void stage_gains(const float* g0, const float* g1, char* smem) {
  int tid = threadIdx.x; asm volatile("" : "+v"(tid));
  const int lane = tid & 63, wave = tid >> 6;
  float* gl = (float*)(smem + 40960 + wave * 512);
  if (lane < 32) {
    const float* gp = lane < 16 ? g0 : g1;
    if (gp) *(float4*)(gl + lane * 4) = *(const float4*)(gp + (lane & 15) * 4);
  }
}

template <int H>
DI void gemm_epilogue(const EpiCfg& e, int M, int m0, f32x4 (&acc)[8][4], char* smem, const float (&rsv)[4]) {
  int tid = threadIdx.x; asm volatile("" : "+v"(tid));
  const int lane = tid & 63, wave = tid >> 6;
  const int l15 = lane & 15, quad = lane >> 4;
  const int wt = wave & 3;
  char* reg = smem + wave * 4352;
  const float* gl = (const float*)(smem + 40960 + wave * 512) + H * 64;
#pragma unroll
  for (int ti = 0; ti < 4; ++ti) {
    float v[4][4];
    {
      const float rs = rsv[ti];
#pragma unroll
      for (int fi = 0; fi < 4; ++fi)
#pragma unroll
        for (int j = 0; j < 4; ++j) v[fi][j] = acc[H * 4 + fi][ti][j] * rs;
      if (e.gain) {
        float ss = 0.f;
#pragma unroll
        for (int fi = 0; fi < 4; ++fi)
#pragma unroll
          for (int j = 0; j < 4; ++j) ss += v[fi][j] * v[fi][j];
        ss += __shfl_xor(ss, 16); ss += __shfl_xor(ss, 32);
        const float r = rsqrtf(ss * (1.f / 64.f) + EPS);
#pragma unroll
        for (int fi = 0; fi < 4; ++fi) {
          float4 g = *(const float4*)(gl + fi * 16 + quad * 4);
          v[fi][0] *= r * g.x; v[fi][1] *= r * g.y; v[fi][2] *= r * g.z; v[fi][3] *= r * g.w;
        }
      }
    }
    const int tokbase = m0 + wt * 64 + ti * 16;
    if (e.o32) {
#pragma unroll
      for (int fi = 0; fi < 4; ++fi) {
        float4 o = {v[fi][0], v[fi][1], v[fi][2], v[fi][3]};
        *(float4*)(reg + l15 * 272 + (fi * 16 + quad * 4) * 4) = o;
      }
#pragma unroll
      for (int i = 0; i < 4; ++i) {
        const int row = i * 4 + quad;
        float4 o = *(const float4*)(reg + row * 272 + l15 * 16);
        const int tok = tokbase + row;
        if (tok < M) {
          *(float4*)(e.o32 + (long)tok * e.ld32 + e.c32 + l15 * 4) = o;
        }
      }
    }
    if (e.ob) {
#pragma unroll
      for (int fi = 0; fi < 4; ++fi) {
        float t[4];
#pragma unroll
        for (int j = 0; j < 4; ++j) {
          float u = v[fi][j] * e.post;
          if (e.act == 1) u = silu_f(u); else if (e.act == 2) u = sigm_f(u);
          t[j] = u;
        }
        uint2 o = {pack2(t[0], t[1]), pack2(t[2], t[3])};
        *(uint2*)(reg + l15 * 144 + (fi * 16 + quad * 4) * 2) = o;
      }
#pragma unroll
      for (int i = 0; i < 2; ++i) {
        const int row = i * 8 + (lane >> 3), c8 = lane & 7;
        uint4 o = *(const uint4*)(reg + row * 144 + c8 * 16);
        const int tok = tokbase + row;
        if (tok < M) {
          *(uint4*)(e.ob + (long)tok * e.ldb + e.cb + c8 * 8) = o;
          if (e.ob2) {
            long row2 = (long)(tok >> 4) * SKS + 2048 + (tok & 15);
            *(uint4*)(e.ob2 + row2 * 512 + e.c2 + c8 * 8) = o;
          }
        }
      }
    }
  }
}

DI EpiCfg epi_inproj(const Params& p, int gidx, bool sample) {
  char* ws = p.ws;
  EpiCfg e{};
  e.rs = (const float*)(ws + (sample ? WS_RSTDS : WS_RSTD));
  e.post = 1.f; e.act = 0;
  e.ob = (u16*)(ws + (sample ? WS_ZS : WS_Z)); e.ldb = NZ; e.cb = gidx * 64;
  if (gidx < 8) { e.gain = p.g_qa; e.post = QSCALE; }
  else if (gidx < 16) {
    e.gain = p.g_ka; e.o32 = p.out + (sample ? O_SK : O_PK); e.ld32 = 512; e.c32 = (gidx - 8) * 64;
    if (sample) { e.ob2 = (u16*)(ws + WS_KS); e.c2 = (gidx - 8) * 64; }
  } else if (gidx < 24) {
    e.o32 = p.out + (sample ? O_SV : O_PV); e.ld32 = 512; e.c32 = (gidx - 16) * 64;
    if (sample) { e.ob2 = (u16*)(ws + WS_VS); e.c2 = (gidx - 16) * 64; }
  } else if (gidx < 32) { e.act = 1; }
  else if (gidx < 36) { }
  else if (gidx < 40) { e.post = 0.125f; }
  else if (gidx < 44) { }
  else if (gidx < 48) { e.act = 2; }
  else if (gidx < 52) { e.act = 1; }
  else if (gidx < 56) { e.gain = p.g_qm; e.post = QSCALE; }
  else { e.act = 1; }
  return e;
}


DI void stagger_wait(int slot, int ticks_per_slot) {
  if (threadIdx.x == 0) {
    const long long t0 = wall_clock64();
    const long long dt = (long long)slot * ticks_per_slot;
    while (wall_clock64() - t0 < dt) __builtin_amdgcn_s_sleep(32);
  }
  __syncthreads();
}

DI void phase1(const Params& p, char* smem) {
  char* ws = p.ws;
  constexpr int T_MAIN = 256 * 15, T_MEM = 32 * 2, T_S = 15;
  const bool xmap = gridDim.x == 256;
  for (int t = blockIdx.x; t < T_MAIN + T_MEM + T_S; t += gridDim.x) {
    const u16* A; const u16* W; int M, mt, nt, kind;
    if (t < T_MAIN) {
      kind = 0; mt = t / 15; nt = t % 15;
      if (xmap) { const int x = blockIdx.x & 7, u = (t >> 8) * 32 + (blockIdx.x >> 3); const int r = u % 60; mt = 32 * x + 4 * (u / 60) + (r & 3); nt = r >> 2; }
      A = (const u16*)(ws + WS_XB); W = (const u16*)(ws + WS_WTIN); M = TP;
    }
    else if (t < T_MAIN + T_MEM) { kind = 1; const int u = t - T_MAIN; mt = u / 2; nt = u % 2; A = (const u16*)(ws + WS_MB); W = (const u16*)(ws + WS_WTM); M = TMEM; }
    else { kind = 2; mt = 0; nt = t - T_MAIN - T_MEM; A = (const u16*)(ws + WS_XSB); W = (const u16*)(ws + WS_WTIN); M = TS; }
    float rsv[4];
    load_rs((const float*)(ws + (kind == 0 ? WS_RSTD : (kind == 1 ? WS_RSTDM : WS_RSTDS))), M, mt * 256, rsv);
    f32x4 acc[8][4];
#if PROBE_DUP == 9
    gemm_mainloop(A, M, W, mt * 256, nt * 256, smem, acc, nullptr);
#endif
    gemm_mainloop(A, M, W, mt * 256, nt * 256, smem, acc, nullptr);
    int tid1 = threadIdx.x; asm volatile("" : "+v"(tid1));
    const int wf_ = tid1 >> 8;
    EpiCfg e0, e1;
    if (kind == 1) {
      EpiCfg e{};
      e.rs = (const float*)(ws + WS_RSTDM); e.post = 1.f;
      e.gain = nt == 0 ? p.g_km : nullptr;
      e.o32 = p.out + (nt == 0 ? O_PMK : O_PMV); e.ld32 = 256;
      e.ob = (u16*)(ws + WS_MKV); e.ldb = 512;
      e.c32 = (wf_ * 2) * 64; e.cb = (nt * 4 + wf_ * 2) * 64;
      e0 = e; e.c32 += 64; e.cb += 64; e1 = e;
    } else {
      e0 = epi_inproj(p, nt * 4 + wf_ * 2, kind == 2);
      e1 = epi_inproj(p, nt * 4 + wf_ * 2 + 1, kind == 2);
    }
    stage_gains(e0.gain, e1.gain, smem);
    gemm_epilogue<0>(e0, M, mt * 256, acc, smem, rsv);
    gemm_epilogue<1>(e1, M, mt * 256, acc, smem, rsv);
#if PROBE_DUP == 5
    gemm_epilogue<0>(e0, M, mt * 256, acc, smem, rsv);
    gemm_epilogue<1>(e1, M, mt * 256, acc, smem, rsv);
#endif
    __syncthreads();
  }
  phase1_late(p, smem);
}

DI void phase3(const Params& p, char* smem) {
  char* ws = p.ws;
  constexpr int T_MAIN = 256 * 4, T_S = 4;
  for (int t = blockIdx.x; t < T_MAIN + T_S; t += gridDim.x) {
    const bool smp = t >= T_MAIN;
    int mt = smp ? 0 : t / 4, nt = smp ? t - T_MAIN : t % 4;
    if (!smp && gridDim.x == 256) { const int x = blockIdx.x & 7, u = (t >> 8) * 32 + (blockIdx.x >> 3); mt = 32 * x + (u >> 2); nt = u & 3; }
    const int M = smp ? TS : TP;
    f32x4 acc[8][4];
    gemm_mainloop((const u16*)(ws + (smp ? WS_MIXS : WS_MIX)), M, (const u16*)(ws + WS_WTOUT), mt * 256, nt * 256, smem, acc, (const u16*)(ws + (smp ? WS_XSB : WS_XB)));
    const float rsv[4] = {1.f, 1.f, 1.f, 1.f};
    int tid3 = threadIdx.x; asm volatile("" : "+v"(tid3));
    const int wf_ = tid3 >> 8;
    EpiCfg e{};
    e.post = 1.f; e.ld32 = 1024;
    e.o32 = p.out + (smp ? O_YS : O_Y); e.c32 = nt * 256 + wf_ * 128;
    gemm_epilogue<0>(e, M, mt * 256, acc, smem, rsv);
    e.c32 += 64;
    gemm_epilogue<1>(e, M, mt * 256, acc, smem, rsv);
#if PROBE_DUP == 5
    gemm_epilogue<1>(e, M, mt * 256, acc, smem, rsv);
    e.c32 -= 64;
    gemm_epilogue<0>(e, M, mt * 256, acc, smem, rsv);
#endif
    __syncthreads();
  }
}

struct AttnArgs {
  const u16* Q; long ldq; int nq;
  const u16* K; const u16* V; long ldk; long ldv; int nkeys;
  int ntile_lo, ntile_hi;
  int qpos0; float slope2; float lam;
  const u16* gate; long ldg;
  u16* out; long ldo;
  const float* gsub;
};

struct AttnLocal {
  const u16* Q; long ldq; int nq;
  const u16* K; const u16* V; long ldk; long ldv; int nkeys;
  int ntile_lo, ntile_hi;
  int qpos0; float slope2; float lam;
  const u16* gate; long ldg;
  u16* out; long ldo;
  const float* gsub;
};
template <int NMAP, int DV, bool ALIBI>
DI void attn_item(const u16* aQ, long aldq, int anq, const u16* aK, const u16* aV, long aldk, long aldv, int ankeys,
                  int antile_lo, int antile_hi, int aqpos0, float aslope2, float alam, const u16* agate, long aldg,
                  u16* aout, long aldo, const float* agsub, char* smem) {
  int tid = threadIdx.x; asm volatile("" : "+v"(tid));
  const int lane = tid & 63, w = tid >> 6;
  const int l15 = lane & 15, quad = lane >> 4, l7 = lane & 7;
  constexpr int KMAPB = 16384;
  constexpr int KB = NMAP * KMAPB;
  constexpr int VSTR = DV * 2 + 32;
  constexpr int VB = 128 * VSTR;
  constexpr int STG = KB + VB;
  constexpr int NKC = NMAP * 2;
  constexpr int NVC = DV / 32;
  constexpr int NDT = DV / 16;
  constexpr int VCR = DV / 8;

  bf16x8 qf[NMAP][2];
  {
    int row = w * 16 + l15; row = row < anq ? row : anq - 1;
#pragma unroll
    for (int m = 0; m < NMAP; ++m)
#pragma unroll
      for (int ks = 0; ks < 2; ++ks)
        qf[m][ks] = __builtin_bit_cast(bf16x8, *(const uint4*)(aQ + (long)row * aldq + m * 64 + ks * 32 + quad * 8));
  }
  f32x4 O[NMAP][NDT];
  float mrun[NMAP], lrun[NMAP];
#pragma unroll
  for (int m = 0; m < NMAP; ++m) {
    mrun[m] = -INFINITY; lrun[m] = 0.f;
#pragma unroll
    for (int dt = 0; dt < NDT; ++dt) O[m][dt] = (f32x4){0.f, 0.f, 0.f, 0.f};
  }
  const int npair = (antile_hi + 1) >> 1;
  const int myt = (w < 4) ? antile_lo : antile_hi;
  uint4 rk0, rk1, rk2, rk3, rv0, rv1, rv2, rv3;
  rk0 = (uint4){0u, 0u, 0u, 0u}; rk1 = rk0; rk2 = rk0; rk3 = rk0; rv0 = rk0; rv1 = rk0; rv2 = rk0; rv3 = rk0;
  typedef unsigned u32x4a_t __attribute__((ext_vector_type(4)));
  const __amdgpu_buffer_rsrc_t rsK = __builtin_amdgcn_make_buffer_rsrc((void*)aK, 0, (int)((long)(ankeys - 1) * aldk * 2 + NMAP * 128), 0x00020000);
  const __amdgpu_buffer_rsrc_t rsV = __builtin_amdgcn_make_buffer_rsrc((void*)aV, 0, (int)((long)(ankeys - 1) * aldv * 2 + DV * 2), 0x00020000);
  const int vkoff = (tid / (NMAP * 8)) * (int)aldk * 2 + (tid % (NMAP * 8)) * 16;
  const int vvoff = (tid / VCR) * (int)aldv * 2 + (tid % VCR) * 16;
  const int kstep = (NT / (NMAP * 8)) * (int)aldk * 2, vstep = (NT / VCR) * (int)aldv * 2;
#define ATTN_BL(rs_, vo_, so_, r_) { const u32x4a_t t_ = __builtin_amdgcn_raw_buffer_load_b128(rs_, vo_, so_, 0); r_ = make_uint4(t_[0], t_[1], t_[2], t_[3]); }
#define ATTN_LOADP(p_) do { const int sk_ = (p_) * 128 * (int)aldk * 2, sv_ = (p_) * 128 * (int)aldv * 2; \
    if (NKC > 0) ATTN_BL(rsK, vkoff, sk_, rk0) if (NKC > 1) ATTN_BL(rsK, vkoff, sk_ + kstep, rk1) \
    if (NKC > 2) ATTN_BL(rsK, vkoff, sk_ + 2 * kstep, rk2) if (NKC > 3) ATTN_BL(rsK, vkoff, sk_ + 3 * kstep, rk3) \
    if (NVC > 0) ATTN_BL(rsV, vvoff, sv_, rv0) if (NVC > 1) ATTN_BL(rsV, vvoff, sv_ + vstep, rv1) \
    if (NVC > 2) ATTN_BL(rsV, vvoff, sv_ + 2 * vstep, rv2) if (NVC > 3) ATTN_BL(rsV, vvoff, sv_ + 3 * vstep, rv3) } while (0)
  constexpr int KSTEPB = (NT / (NMAP * 8)) * 128, VSTEPB = (NT / VCR) * VSTR;
#define ATTN_STOREP(stage_) do { char* sb_ = smem + (stage_) * STG; int t2_ = tid; asm volatile("" : "+v"(t2_)); \
    const int kkey0 = t2_ / (NMAP * 8), kcc0 = t2_ % (NMAP * 8); \
    const int ksto = (kcc0 >> 3) * KMAPB + kkey0 * 128 + (((kcc0 & 7) ^ (kkey0 & 7)) * 16); \
    const int vsto = KB + (t2_ / VCR) * VSTR + (t2_ % VCR) * 16; \
    if (NKC > 0) *(uint4*)(sb_ + ksto) = rk0; if (NKC > 1) *(uint4*)(sb_ + ksto + KSTEPB) = rk1; \
    if (NKC > 2) *(uint4*)(sb_ + ksto + 2 * KSTEPB) = rk2; if (NKC > 3) *(uint4*)(sb_ + ksto + 3 * KSTEPB) = rk3; \
    if (NVC > 0) *(uint4*)(sb_ + vsto) = rv0; if (NVC > 1) *(uint4*)(sb_ + vsto + VSTEPB) = rv1; \
    if (NVC > 2) *(uint4*)(sb_ + vsto + 2 * VSTEPB) = rv2; if (NVC > 3) *(uint4*)(sb_ + vsto + 3 * VSTEPB) = rv3; } while (0)
  const int q4 = l15 >> 2, p4 = l15 & 3;
  ATTN_LOADP(0); ATTN_STOREP(0); __syncthreads();
  uint2 pg[NDT];
  const int grow = (w * 16 + l15) < anq ? (w * 16 + l15) : anq - 1;
  for (int pr = 0; pr < npair; ++pr) {
    ATTN_LOADP(pr + 1 < npair ? pr + 1 : pr);
    if (NDT <= 4) {
#pragma unroll
      for (int dt = 0; dt < NDT; ++dt) pg[dt] = *(const uint2*)(agate + (long)grow * aldg + dt * 16 + quad * 4);
    }
    __builtin_amdgcn_sched_barrier(0);
#pragma unroll
    for (int sub = 0; sub < 2; ++sub) {
      const int t = pr * 2 + sub;
      const char* kb = smem + (pr & 1) * STG + sub * 64 * 128; const char* vb = smem + (pr & 1) * STG + KB + sub * 64 * VSTR;
      unsigned pf[NMAP][2][4];
      const bool partial = ((t + 1) * 64 > ankeys) || (t >= myt);
      const int klim = (t >= myt) ? 0 : ankeys;
      f32x4 sall[NMAP][4];
#pragma unroll
      for (int m = 0; m < NMAP; ++m)
#pragma unroll
        for (int kt = 0; kt < 4; ++kt) {
          const char* kr = kb + m * KMAPB + (kt * 16 + l15) * 128;
          f32x4 z = {0.f, 0.f, 0.f, 0.f};
          z = MFMA(ld_frag(kr + ((quad ^ l7) * 16)), qf[m][0], z);
          sall[m][kt] = MFMA(ld_frag(kr + (((4 + quad) ^ l7) * 16)), qf[m][1], z);
        }
      __builtin_amdgcn_sched_barrier(0);
#pragma unroll
      for (int m = 0; m < NMAP; ++m) {
        f32x4 s[4];
#pragma unroll
        for (int kt = 0; kt < 4; ++kt) s[kt] = sall[m][kt];
        float sb = 0.f;
        if (ALIBI) {
          sb = aslope2 * (float)(t * 64 + quad * 4);
          if ((t + 1) * 64 > aqpos0 + w * 16) {
            const float dq = (float)(aqpos0 + w * 16 + l15 - t * 64 - quad * 4);
            const float qoff = aslope2 * (float)(aqpos0 + w * 16 + l15) - sb;
#pragma unroll
            for (int kt = 0; kt < 4; ++kt)
#pragma unroll
              for (int j = 0; j < 4; ++j) s[kt][j] = fmaf(-aslope2, fabsf(dq - (float)(kt * 16 + j)), s[kt][j]) + qoff;
          } else {
#pragma unroll
            for (int kt = 0; kt < 4; ++kt)
#pragma unroll
              for (int j = 0; j < 4; ++j) s[kt][j] = fmaf(aslope2, (float)(kt * 16 + j), s[kt][j]);
          }
        }
        if (partial) {
#pragma unroll
          for (int kt = 0; kt < 4; ++kt)
#pragma unroll
            for (int j = 0; j < 4; ++j) {
              const bool bad = (t * 64 + kt * 16 + quad * 4 + j) >= klim;
              s[kt][j] = bad ? -INFINITY : s[kt][j];
            }
        }
        float mx = -INFINITY;
#pragma unroll
        for (int kt = 0; kt < 4; ++kt)
#pragma unroll
          for (int j = 0; j < 4; ++j) mx = fmaxf(mx, s[kt][j]);
        mx += sb;
        mx = fmaxf(mx, __shfl_xor(mx, 16)); mx = fmaxf(mx, __shfl_xor(mx, 32));
        const float mnew = fmaxf(mrun[m], mx);
        const float alpha = ex2(mrun[m] - mnew);
        mrun[m] = mnew;
        const float eoff = sb - mnew;
        float psum = 0.f;
#pragma unroll
        for (int kt = 0; kt < 4; ++kt)
#pragma unroll
          for (int j = 0; j < 4; ++j) { float pv = ex2(s[kt][j] + eoff); psum += pv; s[kt][j] = pv; }
        lrun[m] = lrun[m] * alpha + psum;
#pragma unroll
        for (int dt = 0; dt < NDT; ++dt) O[m][dt] *= alpha;
#pragma unroll
        for (int ks2 = 0; ks2 < 2; ++ks2) {
          pf[m][ks2][0] = pack2(s[2 * ks2][0], s[2 * ks2][1]);
          pf[m][ks2][1] = pack2(s[2 * ks2][2], s[2 * ks2][3]);
          pf[m][ks2][2] = pack2(s[2 * ks2 + 1][0], s[2 * ks2 + 1][1]);
          pf[m][ks2][3] = pack2(s[2 * ks2 + 1][2], s[2 * ks2 + 1][3]);
        }
      }
      const char* vl = vb + (quad * 4 + q4) * VSTR + p4 * 8;
#pragma unroll
      for (int ks2 = 0; ks2 < 2; ++ks2)
#pragma unroll
        for (int dt = 0; dt < NDT; ++dt) {
          bf16x8 vf = tr_frag(vl + ks2 * 32 * VSTR + dt * 32, 16 * VSTR);
#pragma unroll
          for (int m = 0; m < NMAP; ++m)
            O[m][dt] = MFMA(vf, mk_frag(pf[m][ks2][0], pf[m][ks2][1], pf[m][ks2][2], pf[m][ks2][3]), O[m][dt]);
        }
    }
    ATTN_STOREP((pr + 1) & 1);
    __syncthreads();
  }
  {
    float l0 = lrun[0]; l0 += __shfl_xor(l0, 16); l0 += __shfl_xor(l0, 32);
    const float inv0 = 1.f / l0;
    float inv1 = 0.f;
    if (NMAP == 2) { float l1 = lrun[NMAP - 1]; l1 += __shfl_xor(l1, 16); l1 += __shfl_xor(l1, 32); inv1 = alam / l1; }
    float ss = 0.f;
#pragma unroll
    for (int dt = 0; dt < NDT; ++dt)
#pragma unroll
      for (int j = 0; j < 4; ++j) {
        float o = O[0][dt][j] * inv0;
        if (NMAP == 2) o -= O[NMAP - 1][dt][j] * inv1;
        O[0][dt][j] = o; ss += o * o;
      }
    float r = 1.f;
    if (NMAP == 2) {
      ss += __shfl_xor(ss, 16); ss += __shfl_xor(ss, 32);
      r = rsqrtf(ss * (1.f / DV) + EPS) * 0.8f;
    }
    const int row = w * 16 + l15;
    if (row < anq) {
#pragma unroll
      for (int dt = 0; dt < NDT; ++dt) {
        const int col = dt * 16 + quad * 4;
        const uint2 g = (NDT <= 4) ? pg[dt] : *(const uint2*)(agate + (long)row * aldg + col);
        float g0 = bf_lo(g.x), g1 = bf_hi(g.x), g2 = bf_lo(g.y), g3 = bf_hi(g.y);
        if (NMAP == 2) { float4 gs = *(const float4*)(agsub + col); g0 *= gs.x; g1 *= gs.y; g2 *= gs.z; g3 *= gs.w; }
        uint2 o = {pack2(O[0][dt][0] * r * g0, O[0][dt][1] * r * g1), pack2(O[0][dt][2] * r * g2, O[0][dt][3] * r * g3)};
        *(uint2*)(aout + (long)row * aldo + col) = o;
      }
    }
  }
}

struct MlstmArgs {
  const u16* Z; int nchunk; int nvalid;
  const float* gif;
  int h;
  const float* C0; const float* n0; float m0; bool has_state;
  u16* mix; long ldm;
  const float* g_mh;
  float* oC; float* oN; float* oM;
};

DI void mlstm_item(const u16* aZ, int anchunk, int anvalid, const float* agif, int ah, const float* aC0, const float* an0, float am0,
                   bool ahas_state, u16* amix, long aldm, const float* ag_mh, float* aoC, float* aoN, float* aoM, char* smem) {
  int tid = threadIdx.x; asm volatile("" : "+v"(tid));
  const int lane = tid & 63, w = tid >> 6;
  const int l15 = lane & 15, quad = lane >> 4;
  const int q4 = l15 >> 2, p4 = l15 & 3;
  constexpr int RS = 160;
  constexpr int TB = 64 * RS;
  constexpr int STG = 3 * TB;
  char* ctb = smem + 2 * STG;
  constexpr int CTB = 80 * RS;
  float* ga = (float*)(ctb + 2 * CTB);
  constexpr int GST = 5 * 64 + 4;
  const bool roleB = w >= 4;
  const int wb = w & 3;
  f32x4 Cacc[5];
#pragma unroll
  for (int dt = 0; dt < 5; ++dt) Cacc[dt] = (f32x4){0.f, 0.f, 0.f, 0.f};
  if (ahas_state && roleB) {
#pragma unroll
    for (int dt = 0; dt < 4; ++dt)
#pragma unroll
      for (int j = 0; j < 4; ++j) Cacc[dt][j] = aC0[(16 * wb + quad * 4 + j) * 64 + dt * 16 + l15];
    if (l15 == 0) {
#pragma unroll
      for (int j = 0; j < 4; ++j) Cacc[4][j] = an0[16 * wb + quad * 4 + j];
    }
  }
  float m0 = am0;
  float pig = 0.f, plf = 0.f;
  const bool gvalid = lane < anvalid;
#define MLSTM_GLOAD(c_) do { \
    const float* gp_ = agif + ((long)(c_) * 64 + (gvalid ? lane : 0)) * 8; \
    pig = gvalid ? gp_[ah] : -INFINITY; plf = gvalid ? gp_[4 + ah] : 0.f; \
  } while (0)
#define MLSTM_SCAN(stage_) do { \
    float* g_ = ga + (stage_) * GST; \
    float b_ = plf; \
    _Pragma("unroll") for (int o = 1; o < 64; o <<= 1) { float u_ = __shfl_up(b_, o); if (lane >= o) b_ += u_; } \
    const float av_ = pig - b_; \
    float pm_ = av_; \
    _Pragma("unroll") for (int o = 1; o < 64; o <<= 1) { float u_ = __shfl_up(pm_, o); if (lane >= o) pm_ = fmaxf(pm_, u_); } \
    const float M_ = fmaxf(m0, pm_); \
    const float ML_ = __shfl(M_, 63), bL_ = __shfl(b_, 63); \
    g_[lane] = av_ * LOG2E; g_[64 + lane] = M_ * LOG2E; g_[128 + lane] = expf(-(b_ + M_)); \
    g_[192 + lane] = expf(m0 - M_); g_[256 + lane] = expf(av_ - ML_); \
    if (lane == 0) g_[320] = expf(m0 - ML_); \
    m0 = bL_ + ML_; \
  } while (0)
#define MLSTM_WRITE_CT(buf_) do { char* ct_ = ctb + (buf_) * CTB; \
    _Pragma("unroll") for (int dt = 0; dt < 5; ++dt) { \
      uint2 o_ = {pack2(Cacc[dt][0], Cacc[dt][1]), pack2(Cacc[dt][2], Cacc[dt][3])}; \
      *(uint2*)(ct_ + (dt * 16 + l15) * RS + (16 * wb + quad * 4) * 2) = o_; \
    } } while (0)
  uint4 rq0, rk0, rv0;
  const int ld_row = tid >> 3, ld_cc = tid & 7;
#define MLSTM_LOADC(c_) do { \
    const int rr_ = ld_row < anvalid ? ld_row : anvalid - 1; \
    const u16* b0_ = aZ + ((long)(c_) * 64 + rr_) * NZ + ah * 64 + ld_cc * 8; \
    rq0 = *(const uint4*)(b0_ + 2048); rk0 = *(const uint4*)(b0_ + 2304); rv0 = *(const uint4*)(b0_ + 2560); \
  } while (0)
#define MLSTM_STOREC(stage_) do { \
    char* sb_ = smem + (stage_) * STG + ld_row * RS + ld_cc * 16; \
    *(uint4*)(sb_) = rq0; *(uint4*)(sb_ + TB) = rk0; *(uint4*)(sb_ + 2 * TB) = rv0; \
  } while (0)
  if (roleB) MLSTM_WRITE_CT(0);
  MLSTM_LOADC(0); MLSTM_STOREC(0);
  MLSTM_LOADC(anchunk > 1 ? 1 : 0);
  if (w == 4) { MLSTM_GLOAD(0); MLSTM_SCAN(0); MLSTM_GLOAD(anchunk > 1 ? 1 : 0); }
  __syncthreads();
  const unsigned ones = (l15 == 0) ? 0x3F803F80u : 0u;
  const bf16x8 onesf = mk_frag(ones, ones, ones, ones);
  for (int c = 0; c < anchunk; ++c) {
    const int stage = c & 1;
    MLSTM_STOREC((c + 1) & 1);
    const int cn = c + 2 < anchunk ? c + 2 : anchunk - 1;
    MLSTM_LOADC(cn);
    if (w == 4) {
      if (c + 1 < anchunk) MLSTM_SCAN((c + 1) & 1);
      MLSTM_GLOAD(cn);
    }
    __builtin_amdgcn_sched_barrier(0);
    const char* ct = ctb + stage * CTB;
    const char* sq = smem + stage * STG; const char* sk = sq + TB; const char* sv = sq + 2 * TB;
    const float* g = ga + stage * GST;
    if (!roleB) {
      const int t = 16 * w + l15;
      const float M2t = g[64 + t], emt = g[128 + t], gwt = g[192 + t];
      uint2 pob[4], pgb[4];
      {
        const int tc = t < anvalid ? t : anvalid - 1;
        const u16* zr = aZ + ((long)c * 64 + tc) * NZ + ah * 64 + quad * 4;
#pragma unroll
        for (int dt = 0; dt < 4; ++dt) { pob[dt] = *(const uint2*)(zr + 2816 + dt * 16); pgb[dt] = *(const uint2*)(zr + 3072 + dt * 16); }
      }
      bf16x8 qf0 = ld_frag(sq + t * RS + quad * 16), qf1 = ld_frag(sq + t * RS + (4 + quad) * 16);
      f32x4 pt[4];
#pragma unroll
      for (int st = 0; st < 4; ++st) {
        pt[st] = (f32x4){0.f, 0.f, 0.f, 0.f};
        if (st <= w) {
          const char* kr = sk + (st * 16 + l15) * RS;
          f32x4 z = {0.f, 0.f, 0.f, 0.f};
          z = MFMA(ld_frag(kr + quad * 16), qf0, z);
          z = MFMA(ld_frag(kr + (4 + quad) * 16), qf1, z);
          float4 a2 = *(const float4*)(g + st * 16 + quad * 4);
          const float av[4] = {a2.x, a2.y, a2.z, a2.w};
#pragma unroll
          for (int j = 0; j < 4; ++j) {
            const int sidx = st * 16 + quad * 4 + j;
            const float dw = (sidx <= t) ? ex2(av[j] - M2t) : 0.f;
            pt[st][j] = z[j] * dw;
          }
        }
      }
      bf16x8 pf[2];
#pragma unroll
      for (int ks2 = 0; ks2 < 2; ++ks2)
        pf[ks2] = mk_frag(pack2(pt[2 * ks2][0], pt[2 * ks2][1]), pack2(pt[2 * ks2][2], pt[2 * ks2][3]),
                          pack2(pt[2 * ks2 + 1][0], pt[2 * ks2 + 1][1]), pack2(pt[2 * ks2 + 1][2], pt[2 * ks2 + 1][3]));
      f32x4 H[5];
      const char* vl = sv + (quad * 4 + q4) * RS + p4 * 8;
#pragma unroll
      for (int dt = 0; dt < 5; ++dt) {
        const char* cr = ct + (dt * 16 + l15) * RS;
        f32x4 z = {0.f, 0.f, 0.f, 0.f};
        z = MFMA(ld_frag(cr + quad * 16), qf0, z);
        z = MFMA(ld_frag(cr + (4 + quad) * 16), qf1, z);
        z *= gwt;
#pragma unroll
        for (int ks2 = 0; ks2 < 2; ++ks2) {
          bf16x8 vf = (dt < 4) ? tr_frag(vl + ks2 * 32 * RS + dt * 32, 16 * RS) : onesf;
          z = MFMA(vf, pf[ks2], z);
        }
        H[dt] = z;
      }
      const float den = __shfl(H[4][0], l15);
      const float sc = 1.f / fmaxf(fabsf(den), emt);
      float ss = 0.f;
#pragma unroll
      for (int dt = 0; dt < 4; ++dt)
#pragma unroll
        for (int j = 0; j < 4; ++j) { float hv = H[dt][j] * sc; H[dt][j] = hv; ss += hv * hv; }
      ss += __shfl_xor(ss, 16); ss += __shfl_xor(ss, 32);
      const float r = rsqrtf(ss * (1.f / 64.f) + EPS);
      if (t < anvalid) {
        u16* mr = amix + ((long)c * 64 + t) * aldm + 512 + ah * 64;
#pragma unroll
        for (int dt = 0; dt < 4; ++dt) {
          const int col = dt * 16 + quad * 4;
          const uint2 ob = pob[dt];
          const uint2 gb = pgb[dt];
          float4 gm = *(const float4*)(ag_mh + col);
          float o0 = H[dt][0] * r * gm.x * bf_lo(ob.x) * bf_lo(gb.x);
          float o1 = H[dt][1] * r * gm.y * bf_hi(ob.x) * bf_hi(gb.x);
          float o2 = H[dt][2] * r * gm.z * bf_lo(ob.y) * bf_lo(gb.y);
          float o3 = H[dt][3] * r * gm.w * bf_hi(ob.y) * bf_hi(gb.y);
          uint2 o = {pack2(o0, o1), pack2(o2, o3)};
          *(uint2*)(mr + col) = o;
        }
      }
    } else {
      const float decay = g[320];
#pragma unroll
      for (int dt = 0; dt < 5; ++dt) Cacc[dt] *= decay;
      const char* kl = sk + (quad * 8 + q4) * RS + 16 * wb * 2 + p4 * 8;
      const char* vl2 = sv + (quad * 8 + q4) * RS + p4 * 8;
#pragma unroll
      for (int ks2 = 0; ks2 < 2; ++ks2) {
        uint2 ka = tr_read(kl + ks2 * 32 * RS), kb2 = tr_read(kl + ks2 * 32 * RS + 4 * RS);
        float4 w0 = *(const float4*)(g + 256 + ks2 * 32 + quad * 8), w1 = *(const float4*)(g + 256 + ks2 * 32 + quad * 8 + 4);
        bf16x8 kw = mk_frag(pack2(bf_lo(ka.x) * w0.x, bf_hi(ka.x) * w0.y), pack2(bf_lo(ka.y) * w0.z, bf_hi(ka.y) * w0.w),
                            pack2(bf_lo(kb2.x) * w1.x, bf_hi(kb2.x) * w1.y), pack2(bf_lo(kb2.y) * w1.z, bf_hi(kb2.y) * w1.w));
#pragma unroll
        for (int dt = 0; dt < 5; ++dt) {
          bf16x8 vf = (dt < 4) ? tr_frag(vl2 + ks2 * 32 * RS + dt * 32, 4 * RS) : onesf;
          Cacc[dt] = MFMA(kw, vf, Cacc[dt]);
        }
      }
    }
    if (roleB) MLSTM_WRITE_CT((c + 1) & 1);
    __syncthreads();
  }
  if (roleB) {
#pragma unroll
    for (int dt = 0; dt < 4; ++dt)
#pragma unroll
      for (int j = 0; j < 4; ++j) aoC[(16 * wb + quad * 4 + j) * 64 + dt * 16 + l15] = Cacc[dt][j];
    if (l15 == 0) {
#pragma unroll
      for (int j = 0; j < 4; ++j) aoN[16 * wb + quad * 4 + j] = Cacc[4][j];
    }
    if (tid == 256) *aoM = m0;
  }
}

DI int next_item(int* counter, int* s_item) {
  __syncthreads();
  if (threadIdx.x == 0) *s_item = atomicAdd(counter, 1);
  __syncthreads();
  return __builtin_amdgcn_readfirstlane(*s_item);
}

DI void phase2(const Params& p, char* smem, int cbase) {
  char* ws = p.ws;
  int* s_item = (int*)(smem + LDS_BYTES - 16);
  int* counters = (int*)(ws + WS_CTL) + cbase;
  const u16* Z = (const u16*)(ws + WS_Z); const u16* ZS = (const u16*)(ws + WS_ZS);
  u16* MIX = (u16*)(ws + WS_MIX); u16* MIXS = (u16*)(ws + WS_MIXS);
  for (int rep = 0; rep < (PROBE_DUP == 6 ? 2 : 1); ++rep)
  while (true) {
    const int it = next_item(counters + 4 + rep * 16, s_item);
    if (it >= 160) break;
    if (it < 128) {
      const int b = it >> 2, h = it & 3;
      mlstm_item(Z + (long)b * 2048 * NZ, 32, 64, (const float*)(ws + WS_GIF) + (long)b * 2048 * 8, h, p.sC, p.sN, 0.f, false,
                 MIX + (long)b * 2048 * 1024, 1024, p.g_mh, p.out + O_PC + (long)(b * 4 + h) * 4096, p.out + O_PN + (b * 4 + h) * 64,
                 p.out + O_PM + b * 4 + h, smem);
    } else {
      const int u = it - 128; const int b = u >> 2, h = u & 3;
      mlstm_item(ZS + (long)b * 16 * NZ, 1, 16, (const float*)(ws + WS_GIFS) + (long)b * 16 * 8, h, p.sC + (long)(b * 4 + h) * 4096,
                 p.sN + (b * 4 + h) * 64, p.sM[b * 4 + h], true, MIXS + (long)b * 16 * 1024, 1024, p.g_mh,
                 p.out + O_SC + (long)(b * 4 + h) * 4096, p.out + O_SN + (b * 4 + h) * 64, p.out + O_SM + b * 4 + h, smem);
    }
  }
  {
    const float lam = ((const float*)(ws + WS_CTL))[1];
    int qmask = 0xff;
    for (int pass = 0; pass < 8; ++pass) {
    if (pass == 1) {
      __syncthreads();
      if (threadIdx.x == 0) {
        int mk = 0;
#pragma unroll
        for (int q = 0; q < 8; ++q) mk |= (__hip_atomic_load(counters + 40 + q, __ATOMIC_RELAXED, __HIP_MEMORY_SCOPE_AGENT) < 4 + 256) ? (1 << q) : 0;
        *s_item = mk;
      }
      __syncthreads();
      qmask = __builtin_amdgcn_readfirstlane(*s_item);
    }
    if (pass > 0 && !((qmask >> (((int)(blockIdx.x & 7) + pass) & 7)) & 1)) continue;
    while (true) {
      const int xq = ((int)(blockIdx.x & 7) + pass) & 7;
      const int iq = next_item(counters + 40 + xq, s_item);
      if (iq >= 4 + 256) break;
      const int it = iq < 4 ? xq * 4 + iq : 32 + xq * 256 + (iq - 4);
      const u16 *aQ, *aK, *aV, *agate; u16* aout; long ldq, ldk; int nq, nkeys, tlo, thi, qpos0, h;
      if (it < 32) {
        const int b = it >> 2; h = it & 3;
        aQ = ZS + (long)b * 16 * NZ + h * 128; ldq = NZ; nq = 16;
        aK = (const u16*)(ws + WS_KS) + (long)b * SKS * 512 + h * 128; aV = (const u16*)(ws + WS_VS) + (long)b * SKS * 512 + h * 128;
        ldk = 512; nkeys = SKS; tlo = 33; thi = 33; qpos0 = 2048;
        agate = ZS + (long)b * 16 * NZ + 1536 + h * 128; aout = MIXS + (long)b * 16 * 1024 + h * 128;
      } else {
        const int u = it - 32; const int grp = u >> 8, rr = u & 255; const int qb = 15 - (rr >> 4); const int bh = grp * 16 + (rr & 15); const int b = bh >> 2; h = bh & 3;
        const long tok0 = (long)b * 2048 + qb * 128;
        aQ = Z + tok0 * NZ + h * 128; ldq = NZ; nq = 128;
        aK = Z + (long)b * 2048 * NZ + 512 + h * 128; aV = Z + (long)b * 2048 * NZ + 1024 + h * 128;
        ldk = NZ; nkeys = 2048; tlo = 2 * qb + 1; thi = 2 * qb + 2; qpos0 = qb * 128;
        agate = Z + tok0 * NZ + 1536 + h * 128; aout = MIX + tok0 * 1024 + h * 128;
      }
      attn_item<2, 128, true>(aQ, ldq, nq, aK, aV, ldk, ldk, nkeys, tlo, thi, qpos0, exp2f(-2.f * (h + 1)) * LOG2E, lam, agate, NZ,
                              aout, 1024, p.g_subln, smem);
    }
    }
  }
  for (int rep = 0; rep < (PROBE_DUP == 8 ? 2 : 1); ++rep)
  while (true) {
    const int it = next_item(counters + 12 + rep * 16, s_item);
    if (it >= 2048 + 32) break;
    const u16 *aQ, *aK, *agate; u16* aout; int nq;
    if (it < 2048) {
      const int tb = it >> 2, h = it & 3; const int b = tb >> 4;
      const long tok0 = (long)tb * 128;
      aQ = Z + tok0 * NZ + 3328 + h * 64; nq = 128;
      aK = (const u16*)(ws + WS_MKV) + (long)b * 256 * 512 + h * 64;
      agate = Z + tok0 * NZ + 3584 + h * 64; aout = MIX + tok0 * 1024 + 768 + h * 64;
    } else {
      const int u = it - 2048; const int b = u >> 2, h = u & 3;
      aQ = ZS + (long)b * 16 * NZ + 3328 + h * 64; nq = 16;
      aK = (const u16*)(ws + WS_MKVS) + (long)b * 256 * 512 + h * 64;
      agate = ZS + (long)b * 16 * NZ + 3584 + h * 64; aout = MIXS + (long)b * 16 * 1024 + 768 + h * 64;
    }
    attn_item<1, 64, false>(aQ, NZ, nq, aK, aK + 256, 512, 512, 256, 4, 4, 0, 0.f, 0.f, agate, NZ, aout, 1024, p.g_subln, smem);
  }
}


DI void grid_barrier(unsigned* ctr, unsigned target) {
  __syncthreads();
  if (threadIdx.x == 0) {
    __builtin_amdgcn_fence(__ATOMIC_RELEASE, "agent");
    asm volatile("s_waitcnt vmcnt(0)" ::: "memory");
    __hip_atomic_fetch_add(ctr, 1u, __ATOMIC_RELAXED, __HIP_MEMORY_SCOPE_AGENT);
    while (__hip_atomic_load(ctr, __ATOMIC_RELAXED, __HIP_MEMORY_SCOPE_AGENT) < target) __builtin_amdgcn_s_sleep(2);
    __builtin_amdgcn_fence(__ATOMIC_ACQUIRE, "agent");
    asm volatile("s_waitcnt vmcnt(0)" ::: "memory");
  }
  __syncthreads();
}

__global__ void __launch_bounds__(512) fwd_megakernel(Params p, int phase_lo, int phase_hi, int coop) {
  extern __shared__ __attribute__((aligned(16))) char smem[];
  cg::grid_group grid = cg::this_grid();
  if (phase_lo <= 0 && phase_hi > 0) phase0(p, smem);
#if PROBE_DUP == 4
  __syncthreads();
  if (phase_lo <= 0 && phase_hi > 0) phase0(p, smem);
#endif
  if (coop) grid.sync();
  if (phase_lo <= 1 && phase_hi > 1) phase1(p, smem);
#if PROBE_DUP == 1
  if (phase_lo <= 1 && phase_hi > 1) phase1(p, smem);
#endif
  unsigned* gctr = (unsigned*)(p.ws + WS_CTL) + 32;
  if (coop) grid_barrier(gctr, gridDim.x);
  if (phase_lo <= 2 && phase_hi > 2) phase2(p, smem, 0);
#if PROBE_DUP == 2
  if (phase_lo <= 2 && phase_hi > 2) phase2(p, smem, 16);
#endif
  if (coop) grid_barrier(gctr, 2u * gridDim.x);
  if (phase_lo <= 3 && phase_hi > 3) phase3(p, smem);
#if PROBE_DUP == 3
  if (phase_lo <= 3 && phase_hi > 3) phase3(p, smem);
#endif
}

extern "C" void kernel_launch(void* const* d_in, const int* in_sizes, int n_in, void* d_out, int out_size,
                              void* d_ws, size_t ws_size, hipStream_t stream) {
  static int grid_blocks = 0;
  if (!grid_blocks) {
    int dev = 0, cus = 0, per_cu = 0;
    (void)hipGetDevice(&dev);
    (void)hipDeviceGetAttribute(&cus, hipDeviceAttributeMultiprocessorCount, dev);
    (void)hipFuncSetAttribute((const void*)fwd_megakernel, hipFuncAttributeMaxDynamicSharedMemorySize, LDS_BYTES);
    (void)hipOccupancyMaxActiveBlocksPerMultiprocessor(&per_cu, fwd_megakernel, 512, LDS_BYTES);
    if (per_cu < 1) per_cu = 1;
    if (per_cu > 1) per_cu = 1;
    grid_blocks = cus * per_cu;
    if (ws_size < WS_END) fprintf(stderr, "workspace too small: %zu < %zu\n", ws_size, (size_t)WS_END);
  }
  Params p{};
  const float** pp = (const float**)&p;
  for (int i = 0; i < 28; ++i) pp[i] = (const float*)d_in[i];
  p.out = (float*)d_out; p.ws = (char*)d_ws;
  int lo = 0, hi = 4, coop = 1;
  void* args[] = {&p, &lo, &hi, &coop};
  hipError_t e = hipLaunchCooperativeKernel((void*)fwd_megakernel, dim3(grid_blocks), dim3(512), args, LDS_BYTES, stream);
  if (e != hipSuccess) fprintf(stderr, "cooperative launch failed: %s (grid %d)\n", hipGetErrorString(e), grid_blocks);
}
```

```cpp
#include <hip/hip_runtime.h>
#include <hip/hip_cooperative_groups.h>
#include <cstdio>
namespace cg = cooperative_groups;

typedef unsigned short u16;
typedef short bf16x8 __attribute__((ext_vector_type(8)));
typedef short s16x4 __attribute__((ext_vector_type(4)));
typedef float f32x4 __attribute__((ext_vector_type(4)));
typedef float f32x2 __attribute__((ext_vector_type(2)));
typedef __bf16 bf16x2_t __attribute__((ext_vector_type(2)));
#define DI __device__ __forceinline__
#define MFMA(a, b, c) __builtin_amdgcn_mfma_f32_16x16x32_bf16((a), (b), (c), 0, 0, 0)

constexpr int DM = 1024;
constexpr int TP = 65536;
constexpr int TS = 128;
constexpr int TMEM = 8192;
constexpr int NZ = 3840;
constexpr int NIN = 3848;
constexpr int SKS = 2064;
constexpr float EPS = 1e-6f;
constexpr float LOG2E = 1.4426950408889634f;
constexpr float QSCALE = 0.125f * LOG2E;

constexpr size_t WS_CTL = 0;
constexpr size_t WS_WTIN = 4096;
constexpr size_t WS_WTOUT = WS_WTIN + (size_t)NZ * 1024 * 2;
constexpr size_t WS_WTM = WS_WTOUT + (size_t)1024 * 1024 * 2;
constexpr size_t WS_XB = WS_WTM + (size_t)512 * 1024 * 2;
constexpr size_t WS_XSB = WS_XB + (size_t)TP * 1024 * 2;
constexpr size_t WS_MB = WS_XSB + (size_t)TS * 1024 * 2;
constexpr size_t WS_RSTD = WS_MB + (size_t)TMEM * 1024 * 2;
constexpr size_t WS_RSTDS = WS_RSTD + (size_t)TP * 4;
constexpr size_t WS_RSTDM = WS_RSTDS + (size_t)TS * 4;
constexpr size_t WS_GIF = WS_RSTDM + (size_t)TMEM * 4;
constexpr size_t WS_GIFS = WS_GIF + (size_t)TP * 8 * 4;
constexpr size_t WS_Z = WS_GIFS + (size_t)TS * 8 * 4;
constexpr size_t WS_ZS = WS_Z + (size_t)TP * NZ * 2;
constexpr size_t WS_MIX = WS_ZS + (size_t)TS * NZ * 2;
constexpr size_t WS_MIXS = WS_MIX + (size_t)TP * 1024 * 2;
constexpr size_t WS_KS = WS_MIXS + (size_t)TS * 1024 * 2;
constexpr size_t WS_VS = WS_KS + (size_t)8 * SKS * 512 * 2;
constexpr size_t WS_MKV = WS_VS + (size_t)8 * SKS * 512 * 2;
constexpr size_t WS_MKVS = WS_MKV + (size_t)TMEM * 512 * 2;
constexpr size_t WS_END = WS_MKVS + (size_t)2048 * 512 * 2;

constexpr long O_Y = 0;
constexpr long O_YS = O_Y + 67108864L;
constexpr long O_PK = O_YS + 131072L;
constexpr long O_PV = O_PK + 33554432L;
constexpr long O_PC = O_PV + 33554432L;
constexpr long O_PN = O_PC + 524288L;
constexpr long O_PM = O_PN + 8192L;
constexpr long O_PMK = O_PM + 128L;
constexpr long O_PMV = O_PMK + 2097152L;
constexpr long O_SK = O_PMV + 2097152L;
constexpr long O_SV = O_SK + 65536L;
constexpr long O_SC = O_SV + 65536L;
constexpr long O_SN = O_SC + 131072L;
constexpr long O_SM = O_SN + 2048L;

constexpr int LDS_BYTES = 143360;
constexpr int NT = 512;
constexpr int NWV = 8;
#ifndef STAG1
#define STAG1 350
#endif
#ifndef STAG3
#define STAG3 450
#endif
#ifndef PROBE_DUP
#define PROBE_DUP 0
#endif

struct Params {
  const float* x; const float* xs; const float* ck; const float* cv; const float* sC; const float* sN; const float* sM;
  const float* cmk; const float* cmv; const float* mem; const float* g_norm; const float* w_in; const float* w_out;
  const float* g_qa; const float* g_ka; const float* lq1; const float* lk1; const float* lq2; const float* lk2;
  const float* g_subln; const float* b_i; const float* b_f; const float* g_mh; const float* g_qm; const float* g_km;
  const float* g_mem; const float* w_mk; const float* w_mv;
  float* out; char* ws;
};

DI unsigned pack2(float a, float b) { f32x2 v = {a, b}; return __builtin_bit_cast(unsigned, __builtin_convertvector(v, bf16x2_t)); }
DI float bf_lo(unsigned u) { return __uint_as_float(u << 16); }
DI float bf_hi(unsigned u) { return __uint_as_float(u & 0xffff0000u); }
DI float ex2(float x) { return __builtin_amdgcn_exp2f(x); }
DI bf16x8 ld_frag(const char* p) { return __builtin_bit_cast(bf16x8, *(const uint4*)p); }
DI bf16x8 mk_frag(unsigned a, unsigned b, unsigned c, unsigned d) { uint4 v = {a, b, c, d}; return __builtin_bit_cast(bf16x8, v); }
DI uint2 tr_read(const char* p) {
  s16x4 r = __builtin_amdgcn_ds_read_tr16_b64_v4i16((__attribute__((address_space(3))) s16x4*)(p));
  return __builtin_bit_cast(uint2, r);
}
DI bf16x8 tr_frag(const char* p, int off2) { uint2 a = tr_read(p), b = tr_read(p + off2); return mk_frag(a.x, a.y, b.x, b.y); }
DI float wave_sum(float v) {
#pragma unroll
  for (int o = 32; o > 0; o >>= 1) v += __shfl_xor(v, o);
  return v;
}
DI float silu_f(float x) { return x * __builtin_amdgcn_rcpf(1.f + __expf(-x)); }
DI float sigm_f(float x) { return __builtin_amdgcn_rcpf(1.f + __expf(-x)); }

DI void phase0(const Params& p, char* smem) {
  const int tid = threadIdx.x, lane = tid & 63, wave = tid >> 6;
  char* ws = p.ws;
  if (blockIdx.x == 0 && wave == 0) {
    float a = wave_sum(p.lq1[lane] * p.lk1[lane]);
    float b = wave_sum(p.lq2[lane] * p.lk2[lane]);
    if (lane == 0) {
      ((int*)(ws + WS_CTL))[4] = 0; ((int*)(ws + WS_CTL))[8] = 0; ((int*)(ws + WS_CTL))[12] = 0;
      ((int*)(ws + WS_CTL))[32] = 0; ((int*)(ws + WS_CTL))[36] = 0;
      for (int q = 40; q < 48; ++q) ((int*)(ws + WS_CTL))[q] = 0;
      ((int*)(ws + WS_CTL))[20] = 0; ((int*)(ws + WS_CTL))[24] = 0; ((int*)(ws + WS_CTL))[28] = 0;
      ((float*)(ws + WS_CTL))[1] = expf(a) - expf(b) + 0.2f;
    }
  }
  float* WG = (float*)smem;
  for (int k = tid; k < 1024; k += NT) {
    float g = p.g_norm[k];
    float4 a = *(const float4*)(p.w_in + (long)k * NIN + 3072);
    float4 b = *(const float4*)(p.w_in + (long)k * NIN + 3076);
    float4 a2 = {a.x * g, a.y * g, a.z * g, a.w * g}, b2 = {b.x * g, b.y * g, b.z * g, b.w * g};
    *(float4*)(WG + k * 8) = a2; *(float4*)(WG + k * 8 + 4) = b2;
  }
  __syncthreads();
  {
    constexpr int RPW = 4;
    const int gw = blockIdx.x * NWV + wave, nw = gridDim.x * NWV;
    constexpr int NROWS = TP + TS + TMEM;
    for (int r0 = gw; r0 < NROWS; r0 += RPW * nw) {
      const float* src[RPW]; u16* dst[RPW]; float* rsp[RPW]; float* gif[RPW]; bool live[RPW];
#pragma unroll
      for (int q = 0; q < RPW; ++q) {
        int r = r0 + q * nw; live[q] = r < NROWS; r = live[q] ? r : r0;
        if (r < TP) { src[q] = p.x + (long)r * 1024; dst[q] = (u16*)(ws + WS_XB) + (long)r * 1024; rsp[q] = (float*)(ws + WS_RSTD) + r; gif[q] = (float*)(ws + WS_GIF) + (long)r * 8; }
        else if (r < TP + TS) { int u = r - TP; src[q] = p.xs + (long)u * 1024; dst[q] = (u16*)(ws + WS_XSB) + (long)u * 1024; rsp[q] = (float*)(ws + WS_RSTDS) + u; gif[q] = (float*)(ws + WS_GIFS) + (long)u * 8; }
        else { int u = r - TP - TS; src[q] = p.mem + (long)u * 1024; dst[q] = (u16*)(ws + WS_MB) + (long)u * 1024; rsp[q] = (float*)(ws + WS_RSTDM) + u; gif[q] = nullptr; }
      }
      float4 vv[RPW][4];
#pragma unroll
      for (int q = 0; q < RPW; ++q)
#pragma unroll
        for (int i = 0; i < 4; ++i) { const f32x4 t_ = __builtin_nontemporal_load((const f32x4*)(src[q] + (i >> 1) * 512 + lane * 8 + (i & 1) * 4)); vv[q][i] = make_float4(t_[0], t_[1], t_[2], t_[3]); }
      float ss[RPW];
#pragma unroll
      for (int q = 0; q < RPW; ++q) {
        ss[q] = 0.f;
#pragma unroll
        for (int i = 0; i < 4; ++i) ss[q] += vv[q][i].x * vv[q][i].x + vv[q][i].y * vv[q][i].y + vv[q][i].z * vv[q][i].z + vv[q][i].w * vv[q][i].w;
      }
#pragma unroll
      for (int o = 32; o > 0; o >>= 1)
#pragma unroll
        for (int q = 0; q < RPW; ++q) ss[q] += __shfl_xor(ss[q], o);
      float rstd[RPW];
#pragma unroll
      for (int q = 0; q < RPW; ++q) {
        rstd[q] = rsqrtf(ss[q] * (1.f / 1024.f) + EPS);
        if (live[q]) {
#pragma unroll
          for (int hh = 0; hh < 2; ++hh) { uint4 o_ = {pack2(vv[q][2 * hh].x, vv[q][2 * hh].y), pack2(vv[q][2 * hh].z, vv[q][2 * hh].w), pack2(vv[q][2 * hh + 1].x, vv[q][2 * hh + 1].y), pack2(vv[q][2 * hh + 1].z, vv[q][2 * hh + 1].w)}; *(uint4*)(dst[q] + hh * 512 + lane * 8) = o_; }
          if (lane == 0) *rsp[q] = rstd[q];
        }
      }
      if (gif[0] || gif[RPW - 1]) {
        float g[RPW][8];
#pragma unroll
        for (int q = 0; q < RPW; ++q)
#pragma unroll
          for (int j = 0; j < 8; ++j) g[q][j] = 0.f;
#pragma unroll
        for (int i = 0; i < 4; ++i)
#pragma unroll
          for (int e = 0; e < 4; ++e) {
            const float* wr = WG + ((i >> 1) * 512 + lane * 8 + (i & 1) * 4 + e) * 8;
            const float4 wa = *(const float4*)wr, wb = *(const float4*)(wr + 4);
#pragma unroll
            for (int q = 0; q < RPW; ++q) {
              const float xv = e == 0 ? vv[q][i].x : (e == 1 ? vv[q][i].y : (e == 2 ? vv[q][i].z : vv[q][i].w));
              g[q][0] += xv * wa.x; g[q][1] += xv * wa.y; g[q][2] += xv * wa.z; g[q][3] += xv * wa.w;
              g[q][4] += xv * wb.x; g[q][5] += xv * wb.y; g[q][6] += xv * wb.z; g[q][7] += xv * wb.w;
            }
          }
        const bool hi = (lane & 32) != 0, h2 = (lane & 16) != 0, h3 = (lane & 8) != 0;
        float c0[RPW];
#pragma unroll
        for (int q = 0; q < RPW; ++q) {
          float a0 = hi ? g[q][4] : g[q][0], a1 = hi ? g[q][5] : g[q][1], a2 = hi ? g[q][6] : g[q][2], a3 = hi ? g[q][7] : g[q][3];
          const float s0 = hi ? g[q][0] : g[q][4], s1 = hi ? g[q][1] : g[q][5], s2 = hi ? g[q][2] : g[q][6], s3 = hi ? g[q][3] : g[q][7];
          a0 += __shfl_xor(s0, 32); a1 += __shfl_xor(s1, 32); a2 += __shfl_xor(s2, 32); a3 += __shfl_xor(s3, 32);
          float b0 = h2 ? a2 : a0, b1 = h2 ? a3 : a1;
          const float t0 = h2 ? a0 : a2, t1 = h2 ? a1 : a3;
          b0 += __shfl_xor(t0, 16); b1 += __shfl_xor(t1, 16);
          float c = h3 ? b1 : b0; const float u0 = h3 ? b0 : b1;
          c += __shfl_xor(u0, 8);
          c0[q] = c;
        }
#pragma unroll
        for (int o = 4; o > 0; o >>= 1)
#pragma unroll
          for (int q = 0; q < RPW; ++q) c0[q] += __shfl_xor(c0[q], o);
        const int jg = 4 * (lane >> 5) + 2 * ((lane >> 4) & 1) + ((lane >> 3) & 1);
        const float bias = jg < 4 ? p.b_i[jg] : p.b_f[jg - 4];
#pragma unroll
        for (int q = 0; q < RPW; ++q) {
          if (live[q] && gif[q] && (lane & 7) == 0) {
            const float xx = c0[q] * rstd[q] + bias;
            gif[q][jg] = jg < 4 ? xx : fminf(xx, 0.f) - log1pf(expf(-fabsf(xx)));
          }
        }
      }
    }
  }
  const long gtid = (long)blockIdx.x * NT + tid, nth = (long)gridDim.x * NT;
  {
    u16* wt = (u16*)(ws + WS_WTIN);
    for (long idx = gtid; idx < (long)NZ * 128; idx += nth) {
      int n = (int)(idx % NZ), kc = (int)(idx / NZ);
      int on = n < 3072 ? n : n + 8;
      float v[8];
#pragma unroll
      for (int e = 0; e < 8; ++e) v[e] = p.w_in[(long)(kc * 8 + e) * NIN + on] * p.g_norm[kc * 8 + e];
      uint4 o = {pack2(v[0], v[1]), pack2(v[2], v[3]), pack2(v[4], v[5]), pack2(v[6], v[7])};
      *(uint4*)(wt + (long)n * 1024 + kc * 8) = o;
    }
    u16* wm = (u16*)(ws + WS_WTM);
    for (long idx = gtid; idx < 512L * 128; idx += nth) {
      int n = (int)(idx % 512), kc = (int)(idx / 512);
      const float* src = n < 256 ? p.w_mk + n : p.w_mv + (n - 256);
      float v[8];
#pragma unroll
      for (int e = 0; e < 8; ++e) v[e] = src[(long)(kc * 8 + e) * 256] * p.g_mem[kc * 8 + e];
      uint4 o = {pack2(v[0], v[1]), pack2(v[2], v[3]), pack2(v[4], v[5]), pack2(v[6], v[7])};
      *(uint4*)(wm + (long)n * 1024 + kc * 8) = o;
    }
  }
}

DI void phase1_late(const Params& p, char* smem) {
  const int tid = threadIdx.x;
  char* ws = p.ws;
  int* s_item = (int*)(smem + LDS_BYTES - 16);
  int* counter = (int*)(ws + WS_CTL) + 36;
  constexpr long N_WO = 1024L * 128, N_KV = 2L * 8 * 2048 * 64, N_MK = 2L * 2048 * 32;
  constexpr int CH = 8192;
  constexpr int NCH = (int)((N_WO + N_KV + N_MK + CH - 1) / CH);
  u16* wo = (u16*)(ws + WS_WTOUT);
  u16* ks = (u16*)(ws + WS_KS); u16* vs = (u16*)(ws + WS_VS);
  u16* mk = (u16*)(ws + WS_MKVS);
  while (true) {
    __syncthreads();
    if (tid == 0) *s_item = atomicAdd(counter, 1);
    __syncthreads();
    const int ch = __builtin_amdgcn_readfirstlane(*s_item);
    if (ch >= NCH) break;
#pragma unroll 4
    for (int i = 0; i < CH / NT; ++i) {
      long idx = (long)ch * CH + i * NT + tid;
      if (idx < N_WO) {
        int n = (int)(idx % 1024), kc = (int)(idx / 1024);
        float v[8];
#pragma unroll
        for (int e = 0; e < 8; ++e) v[e] = p.w_out[(long)(kc * 8 + e) * 1024 + n];
        uint4 o = {pack2(v[0], v[1]), pack2(v[2], v[3]), pack2(v[4], v[5]), pack2(v[6], v[7])};
        *(uint4*)(wo + (long)n * 1024 + kc * 8) = o;
      } else if (idx < N_WO + N_KV) {
        long id = idx - N_WO; const float* srcb = p.ck; u16* dstb = ks;
        if (id >= 8L * 2048 * 64) { id -= 8L * 2048 * 64; srcb = p.cv; dstb = vs; }
        int c = (int)(id & 63); long row = id >> 6; int b = (int)(row >> 11); int rr = (int)(row & 2047);
        const float* sp = srcb + row * 512 + c * 8;
        float4 a = *(const float4*)sp, bb = *(const float4*)(sp + 4);
        uint4 o = {pack2(a.x, a.y), pack2(a.z, a.w), pack2(bb.x, bb.y), pack2(bb.z, bb.w)};
        *(uint4*)(dstb + ((long)b * SKS + rr) * 512 + c * 8) = o;
      } else if (idx < N_WO + N_KV + N_MK) {
        long id = idx - N_WO - N_KV; const float* srcb = p.cmk; int coff = 0;
        if (id >= 2048L * 32) { id -= 2048L * 32; srcb = p.cmv; coff = 256; }
        int c = (int)(id & 31); long row = id >> 5;
        const float* sp = srcb + row * 256 + c * 8;
        float4 a = *(const float4*)sp, bb = *(const float4*)(sp + 4);
        uint4 o = {pack2(a.x, a.y), pack2(a.z, a.w), pack2(bb.x, bb.y), pack2(bb.z, bb.w)};
        *(uint4*)(mk + row * 512 + coff + c * 8) = o;
      }
    }
  }
}

struct EpiCfg {
  const float* rs; const float* gain; float post; int act;
  float* o32; long ld32; int c32;
  u16* ob; long ldb; int cb;
  u16* ob2; int c2;
  const float* resid;
};

DI void gemm_mainloop(const u16* __restrict__ A, int M, const u16* __restrict__ W, int m0, int n0, char* smem, f32x4 (&acc)[8][4], const u16* resid) {
  int tid = threadIdx.x; asm volatile("" : "+v"(tid));
  const int lane = tid & 63, wave = tid >> 6;
  const int l15 = lane & 15, quad = lane >> 4, l7 = lane & 7;
  const int wt = wave & 3, wf_ = wave >> 2;
  const int c8 = tid & 7, r0 = tid >> 3;
  if (resid) {
#pragma unroll
    for (int b = 0; b < 4; ++b) {
      int tok = m0 + wt * 64 + b * 16 + l15; tok = tok < M ? tok : M - 1;
      const u16* xr = resid + (long)tok * 1024 + n0 + wf_ * 128 + quad * 4;
#pragma unroll
      for (int a = 0; a < 8; ++a) { uint2 x2 = *(const uint2*)(xr + a * 16); acc[a][b] = (f32x4){bf_lo(x2.x), bf_hi(x2.x), bf_lo(x2.y), bf_hi(x2.y)}; }
    }
  } else {
#pragma unroll
    for (int a = 0; a < 8; ++a)
#pragma unroll
      for (int b = 0; b < 4; ++b) acc[a][b] = (f32x4){0.f, 0.f, 0.f, 0.f};
  }
  uint4 ra0, ra1, ra2, ra3, rw0, rw1, rw2, rw3;
  const int st_off = r0 * 128 + ((c8 ^ (r0 & 7)) * 16);
  int ar0 = m0 + r0, ar1 = m0 + r0 + 64, ar2 = m0 + r0 + 128, ar3 = m0 + r0 + 192;
  ar0 = ar0 < M ? ar0 : M - 1; ar1 = ar1 < M ? ar1 : M - 1; ar2 = ar2 < M ? ar2 : M - 1; ar3 = ar3 < M ? ar3 : M - 1;
  const u16* pa0 = A + (long)ar0 * 1024 + c8 * 8; const u16* pa1 = A + (long)ar1 * 1024 + c8 * 8;
  const u16* pa2 = A + (long)ar2 * 1024 + c8 * 8; const u16* pa3 = A + (long)ar3 * 1024 + c8 * 8;
  const u16* pw0 = W + (long)(n0 + r0) * 1024 + c8 * 8;
#define GEMM_LOADK(kt_) do { const int ko_ = (kt_) * 64; \
    ra0 = *(const uint4*)(pa0 + ko_); ra1 = *(const uint4*)(pa1 + ko_); ra2 = *(const uint4*)(pa2 + ko_); ra3 = *(const uint4*)(pa3 + ko_); \
    rw0 = *(const uint4*)(pw0 + ko_); rw1 = *(const uint4*)(pw0 + 65536 + ko_); rw2 = *(const uint4*)(pw0 + 131072 + ko_); rw3 = *(const uint4*)(pw0 + 196608 + ko_); \
  } while (0)
#define GEMM_STOREK(stage_) do { char* sa_ = smem + (stage_) * 65536 + st_off; char* sw_ = sa_ + 32768; \
    *(uint4*)(sa_) = ra0; *(uint4*)(sa_ + 8192) = ra1; *(uint4*)(sa_ + 16384) = ra2; *(uint4*)(sa_ + 24576) = ra3; \
    *(uint4*)(sw_) = rw0; *(uint4*)(sw_ + 8192) = rw1; *(uint4*)(sw_ + 16384) = rw2; *(uint4*)(sw_ + 24576) = rw3; \
  } while (0)
  GEMM_LOADK(0); GEMM_STOREK(0); __syncthreads();
  for (int kt = 0; kt < 16; ++kt) {
    GEMM_LOADK(kt + 1 < 16 ? kt + 1 : kt);
    __builtin_amdgcn_sched_barrier(0);
    const char* sa = smem + (kt & 1) * 65536; const char* sw = sa + 32768;
#pragma unroll
    for (int ks = 0; ks < 2; ++ks) {
      const int sw_off = ((ks * 4 + quad) ^ l7) * 16;
      bf16x8 wfr[8];
#pragma unroll
      for (int fi = 0; fi < 8; ++fi) wfr[fi] = ld_frag(sw + (wf_ * 128 + fi * 16 + l15) * 128 + sw_off);
#pragma unroll
      for (int ti = 0; ti < 4; ++ti) {
        const bf16x8 tf = ld_frag(sa + (wt * 64 + ti * 16 + l15) * 128 + sw_off);
#pragma unroll
        for (int fi = 0; fi < 8; ++fi) acc[fi][ti] = MFMA(wfr[fi], tf, acc[fi][ti]);
      }
    }
    GEMM_STOREK((kt + 1) & 1);
    __syncthreads();
  }
}

DI void load_rs(const float* rsp, int M, int m0, float (&rsv)[4]) {
  int tid = threadIdx.x; asm volatile("" : "+v"(tid));
  const int lane = tid & 63, wave = tid >> 6;
  const int l15 = lane & 15, wt = wave & 3;
#pragma unroll
  for (int ti = 0; ti < 4; ++ti) {
    const int tok = m0 + wt * 64 + ti * 16 + l15;
    rsv[ti] = rsp ? rsp[tok < M ? tok : M - 1] : 1.f;
  }
}

DI void stage_gains(const float* g0, const float* g1, char* smem) {
  int tid = threadIdx.x; asm volatile("" : "+v"(tid));
  const int lane = tid & 63, wave = tid >> 6;
  float* gl = (float*)(smem + 40960 + wave * 512);
  if (lane < 32) {
    const float* gp = lane < 16 ? g0 : g1;
    if (gp) *(float4*)(gl + lane * 4) = *(const float4*)(gp + (lane & 15) * 4);
  }
}

template <int H>
DI void gemm_epilogue(const EpiCfg& e, int M, int m0, f32x4 (&acc)[8][4], char* smem, const float (&rsv)[4]) {
  int tid = threadIdx.x; asm volatile("" : "+v"(tid));
  const int lane = tid & 63, wave = tid >> 6;
  const int l15 = lane & 15, quad = lane >> 4;
  const int wt = wave & 3;
  char* reg = smem + wave * 4352;
  const float* gl = (const float*)(smem + 40960 + wave * 512) + H * 64;
#pragma unroll
  for (int ti = 0; ti < 4; ++ti) {
    float v[4][4];
    {
      const float rs = rsv[ti];
#pragma unroll
      for (int fi = 0; fi < 4; ++fi)
#pragma unroll
        for (int j = 0; j < 4; ++j) v[fi][j] = acc[H * 4 + fi][ti][j] * rs;
      if (e.gain) {
        float ss = 0.f;
#pragma unroll
        for (int fi = 0; fi < 4; ++fi)
#pragma unroll
          for (int j = 0; j < 4; ++j) ss += v[fi][j] * v[fi][j];
        ss += __shfl_xor(ss, 16); ss += __shfl_xor(ss, 32);
        const float r = rsqrtf(ss * (1.f / 64.f) + EPS);
#pragma unroll
        for (int fi = 0; fi < 4; ++fi) {
          float4 g = *(const float4*)(gl + fi * 16 + quad * 4);
          v[fi][0] *= r * g.x; v[fi][1] *= r * g.y; v[fi][2] *= r * g.z; v[fi][3] *= r * g.w;
        }
      }
    }
    const int tokbase = m0 + wt * 64 + ti * 16;
    if (e.o32) {
#pragma unroll
      for (int fi = 0; fi < 4; ++fi) {
        float4 o = {v[fi][0], v[fi][1], v[fi][2], v[fi][3]};
        *(float4*)(reg + l15 * 272 + (fi * 16 + quad * 4) * 4) = o;
      }
#pragma unroll
      for (int i = 0; i < 4; ++i) {
        const int row = i * 4 + quad;
        float4 o = *(const float4*)(reg + row * 272 + l15 * 16);
        const int tok = tokbase + row;
        if (tok < M) {
          *(float4*)(e.o32 + (long)tok * e.ld32 + e.c32 + l15 * 4) = o;
        }
      }
    }
    if (e.ob) {
#pragma unroll
      for (int fi = 0; fi < 4; ++fi) {
        float t[4];
#pragma unroll
        for (int j = 0; j < 4; ++j) {
          float u = v[fi][j] * e.post;
          if (e.act == 1) u = silu_f(u); else if (e.act == 2) u = sigm_f(u);
          t[j] = u;
        }
        uint2 o = {pack2(t[0], t[1]), pack2(t[2], t[3])};
        *(uint2*)(reg + l15 * 144 + (fi * 16 + quad * 4) * 2) = o;
      }
#pragma unroll
      for (int i = 0; i < 2; ++i) {
        const int row = i * 8 + (lane >> 3), c8 = lane & 7;
        uint4 o = *(const uint4*)(reg + row * 144 + c8 * 16);
        const int tok = tokbase + row;
        if (tok < M) {
          *(uint4*)(e.ob + (long)tok * e.ldb + e.cb + c8 * 8) = o;
          if (e.ob2) {
            long row2 = (long)(tok >> 4) * SKS + 2048 + (tok & 15);
            *(uint4*)(e.ob2 + row2 * 512 + e.c2 + c8 * 8) = o;
          }
        }
      }
    }
  }
}

DI EpiCfg epi_inproj(const Params& p, int gidx, bool sample) {
  char* ws = p.ws;
  EpiCfg e{};
  e.rs = (const float*)(ws + (sample ? WS_RSTDS : WS_RSTD));
  e.post = 1.f; e.act = 0;
  e.ob = (u16*)(ws + (sample ? WS_ZS : WS_Z)); e.ldb = NZ; e.cb = gidx * 64;
  if (gidx < 8) { e.gain = p.g_qa; e.post = QSCALE; }
  else if (gidx < 16) {
    e.gain = p.g_ka; e.o32 = p.out + (sample ? O_SK : O_PK); e.ld32 = 512; e.c32 = (gidx - 8) * 64;
    if (sample) { e.ob2 = (u16*)(ws + WS_KS); e.c2 = (gidx - 8) * 64; }
  } else if (gidx < 24) {
    e.o32 = p.out + (sample ? O_SV : O_PV); e.ld32 = 512; e.c32 = (gidx - 16) * 64;
    if (sample) { e.ob2 = (u16*)(ws + WS_VS); e.c2 = (gidx - 16) * 64; }
  } else if (gidx < 32) { e.act = 1; }
  else if (gidx < 36) { }
  else if (gidx < 40) { e.post = 0.125f; }
  else if (gidx < 44) { }
  else if (gidx < 48) { e.act = 2; }
  else if (gidx < 52) { e.act = 1; }
  else if (gidx < 56) { e.gain = p.g_qm; e.post = QSCALE; }
  else { e.act = 1; }
  return e;
}


DI void stagger_wait(int slot, int ticks_per_slot) {
  if (threadIdx.x == 0) {
    const long long t0 = wall_clock64();
    const long long dt = (long long)slot * ticks_per_slot;
    while (wall_clock64() - t0 < dt) __builtin_amdgcn_s_sleep(32);
  }
  __syncthreads();
}

DI void phase1(const Params& p, char* smem) {
  char* ws = p.ws;
  constexpr int T_MAIN = 256 * 15, T_MEM = 32 * 2, T_S = 15;
  const bool xmap = gridDim.x == 256;
  for (int t = blockIdx.x; t < T_MAIN + T_MEM + T_S; t += gridDim.x) {
    const u16* A; const u16* W; int M, mt, nt, kind;
    if (t < T_MAIN) {
      kind = 0; mt = t / 15; nt = t % 15;
      if (xmap) { const int x = blockIdx.x & 7, u = (t >> 8) * 32 + (blockIdx.x >> 3); const int r = u % 60; mt = 32 * x + 4 * (u / 60) + (r & 3); nt = r >> 2; }
      A = (const u16*)(ws + WS_XB); W = (const u16*)(ws + WS_WTIN); M = TP;
    }
    else if (t < T_MAIN + T_MEM) { kind = 1; const int u = t - T_MAIN; mt = u / 2; nt = u % 2; A = (const u16*)(ws + WS_MB); W = (const u16*)(ws + WS_WTM); M = TMEM; }
    else { kind = 2; mt = 0; nt = t - T_MAIN - T_MEM; A = (const u16*)(ws + WS_XSB); W = (const u16*)(ws + WS_WTIN); M = TS; }
    float rsv[4];
    load_rs((const float*)(ws + (kind == 0 ? WS_RSTD : (kind == 1 ? WS_RSTDM : WS_RSTDS))), M, mt * 256, rsv);
    f32x4 acc[8][4];
#if PROBE_DUP == 9
    gemm_mainloop(A, M, W, mt * 256, nt * 256, smem, acc, nullptr);
#endif
    gemm_mainloop(A, M, W, mt * 256, nt * 256, smem, acc, nullptr);
    int tid1 = threadIdx.x; asm volatile("" : "+v"(tid1));
    const int wf_ = tid1 >> 8;
    EpiCfg e0, e1;
    if (kind == 1) {
      EpiCfg e{};
      e.rs = (const float*)(ws + WS_RSTDM); e.post = 1.f;
      e.gain = nt == 0 ? p.g_km : nullptr;
      e.o32 = p.out + (nt == 0 ? O_PMK : O_PMV); e.ld32 = 256;
      e.ob = (u16*)(ws + WS_MKV); e.ldb = 512;
      e.c32 = (wf_ * 2) * 64; e.cb = (nt * 4 + wf_ * 2) * 64;
      e0 = e; e.c32 += 64; e.cb += 64; e1 = e;
    } else {
      e0 = epi_inproj(p, nt * 4 + wf_ * 2, kind == 2);
      e1 = epi_inproj(p, nt * 4 + wf_ * 2 + 1, kind == 2);
    }
    stage_gains(e0.gain, e1.gain, smem);
    gemm_epilogue<0>(e0, M, mt * 256, acc, smem, rsv);
    gemm_epilogue<1>(e1, M, mt * 256, acc, smem, rsv);
#if PROBE_DUP == 5
    gemm_epilogue<0>(e0, M, mt * 256, acc, smem, rsv);
    gemm_epilogue<1>(e1, M, mt * 256, acc, smem, rsv);
#endif
    __syncthreads();
  }
  phase1_late(p, smem);
}

DI void phase3(const Params& p, char* smem) {
  char* ws = p.ws;
  constexpr int T_MAIN = 256 * 4, T_S = 4;
  for (int t = blockIdx.x; t < T_MAIN + T_S; t += gridDim.x) {
    const bool smp = t >= T_MAIN;
    int mt = smp ? 0 : t / 4, nt = smp ? t - T_MAIN : t % 4;
    if (!smp && gridDim.x == 256) { const int x = blockIdx.x & 7, u = (t >> 8) * 32 + (blockIdx.x >> 3); mt = 32 * x + (u >> 2); nt = u & 3; }
    const int M = smp ? TS : TP;
    f32x4 acc[8][4];
    gemm_mainloop((const u16*)(ws + (smp ? WS_MIXS : WS_MIX)), M, (const u16*)(ws + WS_WTOUT), mt * 256, nt * 256, smem, acc, (const u16*)(ws + (smp ? WS_XSB : WS_XB)));
    const float rsv[4] = {1.f, 1.f, 1.f, 1.f};
    int tid3 = threadIdx.x; asm volatile("" : "+v"(tid3));
    const int wf_ = tid3 >> 8;
    EpiCfg e{};
    e.post = 1.f; e.ld32 = 1024;
    e.o32 = p.out + (smp ? O_YS : O_Y); e.c32 = nt * 256 + wf_ * 128;
    gemm_epilogue<0>(e, M, mt * 256, acc, smem, rsv);
    e.c32 += 64;
    gemm_epilogue<1>(e, M, mt * 256, acc, smem, rsv);
#if PROBE_DUP == 5
    gemm_epilogue<1>(e, M, mt * 256, acc, smem, rsv);
    e.c32 -= 64;
    gemm_epilogue<0>(e, M, mt * 256, acc, smem, rsv);
#endif
    __syncthreads();
  }
}

struct AttnArgs {
  const u16* Q; long ldq; int nq;
  const u16* K; const u16* V; long ldk; long ldv; int nkeys;
  int ntile_lo, ntile_hi;
  int qpos0; float slope2; float lam;
  const u16* gate; long ldg;
  u16* out; long ldo;
  const float* gsub;
};

struct AttnLocal {
  const u16* Q; long ldq; int nq;
  const u16* K; const u16* V; long ldk; long ldv; int nkeys;
  int ntile_lo, ntile_hi;
  int qpos0; float slope2; float lam;
  const u16* gate; long ldg;
  u16* out; long ldo;
  const float* gsub;
};
template <int NMAP, int DV, bool ALIBI>
DI void attn_item(const u16* aQ, long aldq, int anq, const u16* aK, const u16* aV, long aldk, long aldv, int ankeys,
                  int antile_lo, int antile_hi, int aqpos0, float aslope2, float alam, const u16* agate, long aldg,
                  u16* aout, long aldo, const float* agsub, char* smem) {
  int tid = threadIdx.x; asm volatile("" : "+v"(tid));
  const int lane = tid & 63, w = tid >> 6;
  const int l15 = lane & 15, quad = lane >> 4, l7 = lane & 7;
  constexpr int KMAPB = 16384;
  constexpr int KB = NMAP * KMAPB;
  constexpr int VSTR = DV * 2 + 32;
  constexpr int VB = 128 * VSTR;
  constexpr int STG = KB + VB;
  constexpr int NKC = NMAP * 2;
  constexpr int NVC = DV / 32;
  constexpr int NDT = DV / 16;
  constexpr int VCR = DV / 8;

  bf16x8 qf[NMAP][2];
  {
    int row = w * 16 + l15; row = row < anq ? row : anq - 1;
#pragma unroll
    for (int m = 0; m < NMAP; ++m)
#pragma unroll
      for (int ks = 0; ks < 2; ++ks)
        qf[m][ks] = __builtin_bit_cast(bf16x8, *(const uint4*)(aQ + (long)row * aldq + m * 64 + ks * 32 + quad * 8));
  }
  f32x4 O[NMAP][NDT];
  float mrun[NMAP], lrun[NMAP];
#pragma unroll
  for (int m = 0; m < NMAP; ++m) {
    mrun[m] = -INFINITY; lrun[m] = 0.f;
#pragma unroll
    for (int dt = 0; dt < NDT; ++dt) O[m][dt] = (f32x4){0.f, 0.f, 0.f, 0.f};
  }
  const int npair = (antile_hi + 1) >> 1;
  const int myt = (w < 4) ? antile_lo : antile_hi;
  uint4 rk0, rk1, rk2, rk3, rv0, rv1, rv2, rv3;
  rk0 = (uint4){0u, 0u, 0u, 0u}; rk1 = rk0; rk2 = rk0; rk3 = rk0; rv0 = rk0; rv1 = rk0; rv2 = rk0; rv3 = rk0;
  typedef unsigned u32x4a_t __attribute__((ext_vector_type(4)));
  const __amdgpu_buffer_rsrc_t rsK = __builtin_amdgcn_make_buffer_rsrc((void*)aK, 0, (int)((long)(ankeys - 1) * aldk * 2 + NMAP * 128), 0x00020000);
  const __amdgpu_buffer_rsrc_t rsV = __builtin_amdgcn_make_buffer_rsrc((void*)aV, 0, (int)((long)(ankeys - 1) * aldv * 2 + DV * 2), 0x00020000);
  const int vkoff = (tid / (NMAP * 8)) * (int)aldk * 2 + (tid % (NMAP * 8)) * 16;
  const int vvoff = (tid / VCR) * (int)aldv * 2 + (tid % VCR) * 16;
  const int kstep = (NT / (NMAP * 8)) * (int)aldk * 2, vstep = (NT / VCR) * (int)aldv * 2;
#define ATTN_BL(rs_, vo_, so_, r_) { const u32x4a_t t_ = __builtin_amdgcn_raw_buffer_load_b128(rs_, vo_, so_, 0); r_ = make_uint4(t_[0], t_[1], t_[2], t_[3]); }
#define ATTN_LOADP(p_) do { const int sk_ = (p_) * 128 * (int)aldk * 2, sv_ = (p_) * 128 * (int)aldv * 2; \
    if (NKC > 0) ATTN_BL(rsK, vkoff, sk_, rk0) if (NKC > 1) ATTN_BL(rsK, vkoff, sk_ + kstep, rk1) \
    if (NKC > 2) ATTN_BL(rsK, vkoff, sk_ + 2 * kstep, rk2) if (NKC > 3) ATTN_BL(rsK, vkoff, sk_ + 3 * kstep, rk3) \
    if (NVC > 0) ATTN_BL(rsV, vvoff, sv_, rv0) if (NVC > 1) ATTN_BL(rsV, vvoff, sv_ + vstep, rv1) \
    if (NVC > 2) ATTN_BL(rsV, vvoff, sv_ + 2 * vstep, rv2) if (NVC > 3) ATTN_BL(rsV, vvoff, sv_ + 3 * vstep, rv3) } while (0)
  constexpr int KSTEPB = (NT / (NMAP * 8)) * 128, VSTEPB = (NT / VCR) * VSTR;
#define ATTN_STOREP(stage_) do { char* sb_ = smem + (stage_) * STG; int t2_ = tid; asm volatile("" : "+v"(t2_)); \
    const int kkey0 = t2_ / (NMAP * 8), kcc0 = t2_ % (NMAP * 8); \
    const int ksto = (kcc0 >> 3) * KMAPB + kkey0 * 128 + (((kcc0 & 7) ^ (kkey0 & 7)) * 16); \
    const int vsto = KB + (t2_ / VCR) * VSTR + (t2_ % VCR) * 16; \
    if (NKC > 0) *(uint4*)(sb_ + ksto) = rk0; if (NKC > 1) *(uint4*)(sb_ + ksto + KSTEPB) = rk1; \
    if (NKC > 2) *(uint4*)(sb_ + ksto + 2 * KSTEPB) = rk2; if (NKC > 3) *(uint4*)(sb_ + ksto + 3 * KSTEPB) = rk3; \
    if (NVC > 0) *(uint4*)(sb_ + vsto) = rv0; if (NVC > 1) *(uint4*)(sb_ + vsto + VSTEPB) = rv1; \
    if (NVC > 2) *(uint4*)(sb_ + vsto + 2 * VSTEPB) = rv2; if (NVC > 3) *(uint4*)(sb_ + vsto + 3 * VSTEPB) = rv3; } while (0)
  const int q4 = l15 >> 2, p4 = l15 & 3;
  ATTN_LOADP(0); ATTN_STOREP(0); __syncthreads();
  uint2 pg[NDT];
  const int grow = (w * 16 + l15) < anq ? (w * 16 + l15) : anq - 1;
  for (int pr = 0; pr < npair; ++pr) {
    ATTN_LOADP(pr + 1 < npair ? pr + 1 : pr);
    if (NDT <= 4) {
#pragma unroll
      for (int dt = 0; dt < NDT; ++dt) pg[dt] = *(const uint2*)(agate + (long)grow * aldg + dt * 16 + quad * 4);
    }
    __builtin_amdgcn_sched_barrier(0);
#pragma unroll
    for (int sub = 0; sub < 2; ++sub) {
      const int t = pr * 2 + sub;
      const char* kb = smem + (pr & 1) * STG + sub * 64 * 128; const char* vb = smem + (pr & 1) * STG + KB + sub * 64 * VSTR;
      unsigned pf[NMAP][2][4];
      const bool partial = ((t + 1) * 64 > ankeys) || (t >= myt);
      const int klim = (t >= myt) ? 0 : ankeys;
      f32x4 sall[NMAP][4];
#pragma unroll
      for (int m = 0; m < NMAP; ++m)
#pragma unroll
        for (int kt = 0; kt < 4; ++kt) {
          const char* kr = kb + m * KMAPB + (kt * 16 + l15) * 128;
          f32x4 z = {0.f, 0.f, 0.f, 0.f};
          z = MFMA(ld_frag(kr + ((quad ^ l7) * 16)), qf[m][0], z);
          sall[m][kt] = MFMA(ld_frag(kr + (((4 + quad) ^ l7) * 16)), qf[m][1], z);
        }
      __builtin_amdgcn_sched_barrier(0);
#pragma unroll
      for (int m = 0; m < NMAP; ++m) {
        f32x4 s[4];
#pragma unroll
        for (int kt = 0; kt < 4; ++kt) s[kt] = sall[m][kt];
        float sb = 0.f;
        if (ALIBI) {
          sb = aslope2 * (float)(t * 64 + quad * 4);
          if ((t + 1) * 64 > aqpos0 + w * 16) {
            const float dq = (float)(aqpos0 + w * 16 + l15 - t * 64 - quad * 4);
            const float qoff = aslope2 * (float)(aqpos0 + w * 16 + l15) - sb;
#pragma unroll
            for (int kt = 0; kt < 4; ++kt)
#pragma unroll
              for (int j = 0; j < 4; ++j) s[kt][j] = fmaf(-aslope2, fabsf(dq - (float)(kt * 16 + j)), s[kt][j]) + qoff;
          } else {
#pragma unroll
            for (int kt = 0; kt < 4; ++kt)
#pragma unroll
              for (int j = 0; j < 4; ++j) s[kt][j] = fmaf(aslope2, (float)(kt * 16 + j), s[kt][j]);
          }
        }
        if (partial) {
#pragma unroll
          for (int kt = 0; kt < 4; ++kt)
#pragma unroll
            for (int j = 0; j < 4; ++j) {
              const bool bad = (t * 64 + kt * 16 + quad * 4 + j) >= klim;
              s[kt][j] = bad ? -INFINITY : s[kt][j];
            }
        }
        float mx = -INFINITY;
#pragma unroll
        for (int kt = 0; kt < 4; ++kt)
#pragma unroll
          for (int j = 0; j < 4; ++j) mx = fmaxf(mx, s[kt][j]);
        mx += sb;
        mx = fmaxf(mx, __shfl_xor(mx, 16)); mx = fmaxf(mx, __shfl_xor(mx, 32));
        const float mnew = fmaxf(mrun[m], mx);
        const float alpha = ex2(mrun[m] - mnew);
        mrun[m] = mnew;
        const float eoff = sb - mnew;
        float psum = 0.f;
#pragma unroll
        for (int kt = 0; kt < 4; ++kt)
#pragma unroll
          for (int j = 0; j < 4; ++j) { float pv = ex2(s[kt][j] + eoff); psum += pv; s[kt][j] = pv; }
        lrun[m] = lrun[m] * alpha + psum;
#pragma unroll
        for (int dt = 0; dt < NDT; ++dt) O[m][dt] *= alpha;
#pragma unroll
        for (int ks2 = 0; ks2 < 2; ++ks2) {
          pf[m][ks2][0] = pack2(s[2 * ks2][0], s[2 * ks2][1]);
          pf[m][ks2][1] = pack2(s[2 * ks2][2], s[2 * ks2][3]);
          pf[m][ks2][2] = pack2(s[2 * ks2 + 1][0], s[2 * ks2 + 1][1]);
          pf[m][ks2][3] = pack2(s[2 * ks2 + 1][2], s[2 * ks2 + 1][3]);
        }
      }
      const char* vl = vb + (quad * 4 + q4) * VSTR + p4 * 8;
#pragma unroll
      for (int ks2 = 0; ks2 < 2; ++ks2)
#pragma unroll
        for (int dt = 0; dt < NDT; ++dt) {
          bf16x8 vf = tr_frag(vl + ks2 * 32 * VSTR + dt * 32, 16 * VSTR);
#pragma unroll
          for (int m = 0; m < NMAP; ++m)
            O[m][dt] = MFMA(vf, mk_frag(pf[m][ks2][0], pf[m][ks2][1], pf[m][ks2][2], pf[m][ks2][3]), O[m][dt]);
        }
    }
    ATTN_STOREP((pr + 1) & 1);
    __syncthreads();
  }
  {
    float l0 = lrun[0]; l0 += __shfl_xor(l0, 16); l0 += __shfl_xor(l0, 32);
    const float inv0 = 1.f / l0;
    float inv1 = 0.f;
    if (NMAP == 2) { float l1 = lrun[NMAP - 1]; l1 += __shfl_xor(l1, 16); l1 += __shfl_xor(l1, 32); inv1 = alam / l1; }
    float ss = 0.f;
#pragma unroll
    for (int dt = 0; dt < NDT; ++dt)
#pragma unroll
      for (int j = 0; j < 4; ++j) {
        float o = O[0][dt][j] * inv0;
        if (NMAP == 2) o -= O[NMAP - 1][dt][j] * inv1;
        O[0][dt][j] = o; ss += o * o;
      }
    float r = 1.f;
    if (NMAP == 2) {
      ss += __shfl_xor(ss, 16); ss += __shfl_xor(ss, 32);
      r = rsqrtf(ss * (1.f / DV) + EPS) * 0.8f;
    }
    const int row = w * 16 + l15;
    if (row < anq) {
#pragma unroll
      for (int dt = 0; dt < NDT; ++dt) {
        const int col = dt * 16 + quad * 4;
        const uint2 g = (NDT <= 4) ? pg[dt] : *(const uint2*)(agate + (long)row * aldg + col);
        float g0 = bf_lo(g.x), g1 = bf_hi(g.x), g2 = bf_lo(g.y), g3 = bf_hi(g.y);
        if (NMAP == 2) { float4 gs = *(const float4*)(agsub + col); g0 *= gs.x; g1 *= gs.y; g2 *= gs.z; g3 *= gs.w; }
        uint2 o = {pack2(O[0][dt][0] * r * g0, O[0][dt][1] * r * g1), pack2(O[0][dt][2] * r * g2, O[0][dt][3] * r * g3)};
        *(uint2*)(aout + (long)row * aldo + col) = o;
      }
    }
  }
}

struct MlstmArgs {
  const u16* Z; int nchunk; int nvalid;
  const float* gif;
  int h;
  const float* C0; const float* n0; float m0; bool has_state;
  u16* mix; long ldm;
  const float* g_mh;
  float* oC; float* oN; float* oM;
};

DI void mlstm_item(const u16* aZ, int anchunk, int anvalid, const float* agif, int ah, const float* aC0, const float* an0, float am0,
                   bool ahas_state, u16* amix, long aldm, const float* ag_mh, float* aoC, float* aoN, float* aoM, char* smem) {
  int tid = threadIdx.x; asm volatile("" : "+v"(tid));
  const int lane = tid & 63, w = tid >> 6;
  const int l15 = lane & 15, quad = lane >> 4;
  const int q4 = l15 >> 2, p4 = l15 & 3;
  constexpr int RS = 160;
  constexpr int TB = 64 * RS;
  constexpr int STG = 3 * TB;
  char* ctb = smem + 2 * STG;
  constexpr int CTB = 80 * RS;
  float* ga = (float*)(ctb + 2 * CTB);
  constexpr int GST = 5 * 64 + 4;
  const bool roleB = w >= 4;
  const int wb = w & 3;
  f32x4 Cacc[5];
#pragma unroll
  for (int dt = 0; dt < 5; ++dt) Cacc[dt] = (f32x4){0.f, 0.f, 0.f, 0.f};
  if (ahas_state && roleB) {
#pragma unroll
    for (int dt = 0; dt < 4; ++dt)
#pragma unroll
      for (int j = 0; j < 4; ++j) Cacc[dt][j] = aC0[(16 * wb + quad * 4 + j) * 64 + dt * 16 + l15];
    if (l15 == 0) {
#pragma unroll
      for (int j = 0; j < 4; ++j) Cacc[4][j] = an0[16 * wb + quad * 4 + j];
    }
  }
  float m0 = am0;
  float pig = 0.f, plf = 0.f;
  const bool gvalid = lane < anvalid;
#define MLSTM_GLOAD(c_) do { \
    const float* gp_ = agif + ((long)(c_) * 64 + (gvalid ? lane : 0)) * 8; \
    pig = gvalid ? gp_[ah] : -INFINITY; plf = gvalid ? gp_[4 + ah] : 0.f; \
  } while (0)
#define MLSTM_SCAN(stage_) do { \
    float* g_ = ga + (stage_) * GST; \
    float b_ = plf; \
    _Pragma("unroll") for (int o = 1; o < 64; o <<= 1) { float u_ = __shfl_up(b_, o); if (lane >= o) b_ += u_; } \
    const float av_ = pig - b_; \
    float pm_ = av_; \
    _Pragma("unroll") for (int o = 1; o < 64; o <<= 1) { float u_ = __shfl_up(pm_, o); if (lane >= o) pm_ = fmaxf(pm_, u_); } \
    const float M_ = fmaxf(m0, pm_); \
    const float ML_ = __shfl(M_, 63), bL_ = __shfl(b_, 63); \
    g_[lane] = av_ * LOG2E; g_[64 + lane] = M_ * LOG2E; g_[128 + lane] = expf(-(b_ + M_)); \
    g_[192 + lane] = expf(m0 - M_); g_[256 + lane] = expf(av_ - ML_); \
    if (lane == 0) g_[320] = expf(m0 - ML_); \
    m0 = bL_ + ML_; \
  } while (0)
#define MLSTM_WRITE_CT(buf_) do { char* ct_ = ctb + (buf_) * CTB; \
    _Pragma("unroll") for (int dt = 0; dt < 5; ++dt) { \
      uint2 o_ = {pack2(Cacc[dt][0], Cacc[dt][1]), pack2(Cacc[dt][2], Cacc[dt][3])}; \
      *(uint2*)(ct_ + (dt * 16 + l15) * RS + (16 * wb + quad * 4) * 2) = o_; \
    } } while (0)
  uint4 rq0, rk0, rv0;
  const int ld_row = tid >> 3, ld_cc = tid & 7;
  typedef unsigned u32x4m_t __attribute__((ext_vector_type(4)));
  const __amdgpu_buffer_rsrc_t rsZ = __builtin_amdgcn_make_buffer_rsrc((void*)aZ, 0, 0x7fffffff, 0x00020000);
  const int mvoff = ((ld_row < anvalid ? ld_row : anvalid - 1) * NZ + ah * 64 + ld_cc * 8) * 2;
#define MLSTM_BL(so_, r_) { const u32x4m_t t_ = __builtin_amdgcn_raw_buffer_load_b128(rsZ, mvoff, so_, 0); r_ = make_uint4(t_[0], t_[1], t_[2], t_[3]); }
#define MLSTM_LOADC(c_) do { const int so_ = (c_) * 64 * NZ * 2; \
    MLSTM_BL(so_ + 2048 * 2, rq0) MLSTM_BL(so_ + 2304 * 2, rk0) MLSTM_BL(so_ + 2560 * 2, rv0) \
  } while (0)
#define MLSTM_STOREC(stage_) do { \
    char* sb_ = smem + (stage_) * STG + ld_row * RS + ld_cc * 16; \
    *(uint4*)(sb_) = rq0; *(uint4*)(sb_ + TB) = rk0; *(uint4*)(sb_ + 2 * TB) = rv0; \
  } while (0)
  if (roleB) MLSTM_WRITE_CT(0);
  MLSTM_LOADC(0); MLSTM_STOREC(0);
  MLSTM_LOADC(anchunk > 1 ? 1 : 0);
  if (w == 4) { MLSTM_GLOAD(0); MLSTM_SCAN(0); MLSTM_GLOAD(anchunk > 1 ? 1 : 0); }
  __syncthreads();
  const unsigned ones = (l15 == 0) ? 0x3F803F80u : 0u;
  const bf16x8 onesf = mk_frag(ones, ones, ones, ones);
  for (int c = 0; c < anchunk; ++c) {
    const int stage = c & 1;
    MLSTM_STOREC((c + 1) & 1);
    const int cn = c + 2 < anchunk ? c + 2 : anchunk - 1;
    MLSTM_LOADC(cn);
    if (w == 4) {
      if (c + 1 < anchunk) MLSTM_SCAN((c + 1) & 1);
      MLSTM_GLOAD(cn);
    }
    __builtin_amdgcn_sched_barrier(0);
    const char* ct = ctb + stage * CTB;
    const char* sq = smem + stage * STG; const char* sk = sq + TB; const char* sv = sq + 2 * TB;
    const float* g = ga + stage * GST;
    if (!roleB) {
      const int t = 16 * w + l15;
      const float M2t = g[64 + t], emt = g[128 + t], gwt = g[192 + t];
      uint2 pob[4], pgb[4];
      {
        const int tc = t < anvalid ? t : anvalid - 1;
        const u16* zr = aZ + ((long)c * 64 + tc) * NZ + ah * 64 + quad * 4;
#pragma unroll
        for (int dt = 0; dt < 4; ++dt) { pob[dt] = *(const uint2*)(zr + 2816 + dt * 16); pgb[dt] = *(const uint2*)(zr + 3072 + dt * 16); }
      }
      bf16x8 qf0 = ld_frag(sq + t * RS + quad * 16), qf1 = ld_frag(sq + t * RS + (4 + quad) * 16);
      f32x4 pt[4];
#pragma unroll
      for (int st = 0; st < 4; ++st) {
        pt[st] = (f32x4){0.f, 0.f, 0.f, 0.f};
        if (st <= w) {
          const char* kr = sk + (st * 16 + l15) * RS;
          f32x4 z = {0.f, 0.f, 0.f, 0.f};
          z = MFMA(ld_frag(kr + quad * 16), qf0, z);
          z = MFMA(ld_frag(kr + (4 + quad) * 16), qf1, z);
          float4 a2 = *(const float4*)(g + st * 16 + quad * 4);
          const float av[4] = {a2.x, a2.y, a2.z, a2.w};
#pragma unroll
          for (int j = 0; j < 4; ++j) {
            const int sidx = st * 16 + quad * 4 + j;
            const float dw = (sidx <= t) ? ex2(av[j] - M2t) : 0.f;
            pt[st][j] = z[j] * dw;
          }
        }
      }
      bf16x8 pf[2];
#pragma unroll
      for (int ks2 = 0; ks2 < 2; ++ks2)
        pf[ks2] = mk_frag(pack2(pt[2 * ks2][0], pt[2 * ks2][1]), pack2(pt[2 * ks2][2], pt[2 * ks2][3]),
                          pack2(pt[2 * ks2 + 1][0], pt[2 * ks2 + 1][1]), pack2(pt[2 * ks2 + 1][2], pt[2 * ks2 + 1][3]));
      f32x4 H[5];
      const char* vl = sv + (quad * 4 + q4) * RS + p4 * 8;
#pragma unroll
      for (int dt = 0; dt < 5; ++dt) {
        const char* cr = ct + (dt * 16 + l15) * RS;
        f32x4 z = {0.f, 0.f, 0.f, 0.f};
        z = MFMA(ld_frag(cr + quad * 16), qf0, z);
        z = MFMA(ld_frag(cr + (4 + quad) * 16), qf1, z);
        z *= gwt;
#pragma unroll
        for (int ks2 = 0; ks2 < 2; ++ks2) {
          bf16x8 vf = (dt < 4) ? tr_frag(vl + ks2 * 32 * RS + dt * 32, 16 * RS) : onesf;
          z = MFMA(vf, pf[ks2], z);
        }
        H[dt] = z;
      }
      const float den = __shfl(H[4][0], l15);
      const float sc = 1.f / fmaxf(fabsf(den), emt);
      float ss = 0.f;
#pragma unroll
      for (int dt = 0; dt < 4; ++dt)
#pragma unroll
        for (int j = 0; j < 4; ++j) { float hv = H[dt][j] * sc; H[dt][j] = hv; ss += hv * hv; }
      ss += __shfl_xor(ss, 16); ss += __shfl_xor(ss, 32);
      const float r = rsqrtf(ss * (1.f / 64.f) + EPS);
      if (t < anvalid) {
        u16* mr = amix + ((long)c * 64 + t) * aldm + 512 + ah * 64;
#pragma unroll
        for (int dt = 0; dt < 4; ++dt) {
          const int col = dt * 16 + quad * 4;
          const uint2 ob = pob[dt];
          const uint2 gb = pgb[dt];
          float4 gm = *(const float4*)(ag_mh + col);
          float o0 = H[dt][0] * r * gm.x * bf_lo(ob.x) * bf_lo(gb.x);
          float o1 = H[dt][1] * r * gm.y * bf_hi(ob.x) * bf_hi(gb.x);
          float o2 = H[dt][2] * r * gm.z * bf_lo(ob.y) * bf_lo(gb.y);
          float o3 = H[dt][3] * r * gm.w * bf_hi(ob.y) * bf_hi(gb.y);
          uint2 o = {pack2(o0, o1), pack2(o2, o3)};
          *(uint2*)(mr + col) = o;
        }
      }
    } else {
      const float decay = g[320];
#pragma unroll
      for (int dt = 0; dt < 5; ++dt) Cacc[dt] *= decay;
      const char* kl = sk + (quad * 8 + q4) * RS + 16 * wb * 2 + p4 * 8;
      const char* vl2 = sv + (quad * 8 + q4) * RS + p4 * 8;
#pragma unroll
      for (int ks2 = 0; ks2 < 2; ++ks2) {
        uint2 ka = tr_read(kl + ks2 * 32 * RS), kb2 = tr_read(kl + ks2 * 32 * RS + 4 * RS);
        float4 w0 = *(const float4*)(g + 256 + ks2 * 32 + quad * 8), w1 = *(const float4*)(g + 256 + ks2 * 32 + quad * 8 + 4);
        bf16x8 kw = mk_frag(pack2(bf_lo(ka.x) * w0.x, bf_hi(ka.x) * w0.y), pack2(bf_lo(ka.y) * w0.z, bf_hi(ka.y) * w0.w),
                            pack2(bf_lo(kb2.x) * w1.x, bf_hi(kb2.x) * w1.y), pack2(bf_lo(kb2.y) * w1.z, bf_hi(kb2.y) * w1.w));
#pragma unroll
        for (int dt = 0; dt < 5; ++dt) {
          bf16x8 vf = (dt < 4) ? tr_frag(vl2 + ks2 * 32 * RS + dt * 32, 4 * RS) : onesf;
          Cacc[dt] = MFMA(kw, vf, Cacc[dt]);
        }
      }
    }
    if (roleB) MLSTM_WRITE_CT((c + 1) & 1);
    __syncthreads();
  }
  if (roleB) {
#pragma unroll
    for (int dt = 0; dt < 4; ++dt)
#pragma unroll
      for (int j = 0; j < 4; ++j) aoC[(16 * wb + quad * 4 + j) * 64 + dt * 16 + l15] = Cacc[dt][j];
    if (l15 == 0) {
#pragma unroll
      for (int j = 0; j < 4; ++j) aoN[16 * wb + quad * 4 + j] = Cacc[4][j];
    }
    if (tid == 256) *aoM = m0;
  }
}

DI int next_item(int* counter, int* s_item) {
  __syncthreads();
  if (threadIdx.x == 0) *s_item = atomicAdd(counter, 1);
  __syncthreads();
  return __builtin_amdgcn_readfirstlane(*s_item);
}

DI void phase2(const Params& p, char* smem, int cbase) {
  char* ws = p.ws;
  int* s_item = (int*)(smem + LDS_BYTES - 16);
  int* counters = (int*)(ws + WS_CTL) + cbase;
  const u16* Z = (const u16*)(ws + WS_Z); const u16* ZS = (const u16*)(ws + WS_ZS);
  u16* MIX = (u16*)(ws + WS_MIX); u16* MIXS = (u16*)(ws + WS_MIXS);
  for (int rep = 0; rep < (PROBE_DUP == 6 ? 2 : 1); ++rep)
  while (true) {
    const int it = next_item(counters + 4 + rep * 16, s_item);
    if (it >= 160) break;
    if (it < 128) {
      const int b = it >> 2, h = it & 3;
      mlstm_item(Z + (long)b * 2048 * NZ, 32, 64, (const float*)(ws + WS_GIF) + (long)b * 2048 * 8, h, p.sC, p.sN, 0.f, false,
                 MIX + (long)b * 2048 * 1024, 1024, p.g_mh, p.out + O_PC + (long)(b * 4 + h) * 4096, p.out + O_PN + (b * 4 + h) * 64,
                 p.out + O_PM + b * 4 + h, smem);
    } else {
      const int u = it - 128; const int b = u >> 2, h = u & 3;
      mlstm_item(ZS + (long)b * 16 * NZ, 1, 16, (const float*)(ws + WS_GIFS) + (long)b * 16 * 8, h, p.sC + (long)(b * 4 + h) * 4096,
                 p.sN + (b * 4 + h) * 64, p.sM[b * 4 + h], true, MIXS + (long)b * 16 * 1024, 1024, p.g_mh,
                 p.out + O_SC + (long)(b * 4 + h) * 4096, p.out + O_SN + (b * 4 + h) * 64, p.out + O_SM + b * 4 + h, smem);
    }
  }
  {
    const float lam = ((const float*)(ws + WS_CTL))[1];
    for (int pass = 0; pass < 8; ++pass)
    while (true) {
      const int xq = ((int)(blockIdx.x & 7) + pass) & 7;
      const int iq = next_item(counters + 40 + xq, s_item);
      if (iq >= 4 + 256) break;
      const int it = iq < 4 ? xq * 4 + iq : 32 + xq * 256 + (iq - 4);
      const u16 *aQ, *aK, *aV, *agate; u16* aout; long ldq, ldk; int nq, nkeys, tlo, thi, qpos0, h;
      if (it < 32) {
        const int b = it >> 2; h = it & 3;
        aQ = ZS + (long)b * 16 * NZ + h * 128; ldq = NZ; nq = 16;
        aK = (const u16*)(ws + WS_KS) + (long)b * SKS * 512 + h * 128; aV = (const u16*)(ws + WS_VS) + (long)b * SKS * 512 + h * 128;
        ldk = 512; nkeys = SKS; tlo = 33; thi = 33; qpos0 = 2048;
        agate = ZS + (long)b * 16 * NZ + 1536 + h * 128; aout = MIXS + (long)b * 16 * 1024 + h * 128;
      } else {
        const int u = it - 32; const int grp = u >> 8, rr = u & 255; const int qb = 15 - (rr >> 4); const int bh = grp * 16 + (rr & 15); const int b = bh >> 2; h = bh & 3;
        const long tok0 = (long)b * 2048 + qb * 128;
        aQ = Z + tok0 * NZ + h * 128; ldq = NZ; nq = 128;
        aK = Z + (long)b * 2048 * NZ + 512 + h * 128; aV = Z + (long)b * 2048 * NZ + 1024 + h * 128;
        ldk = NZ; nkeys = 2048; tlo = 2 * qb + 1; thi = 2 * qb + 2; qpos0 = qb * 128;
        agate = Z + tok0 * NZ + 1536 + h * 128; aout = MIX + tok0 * 1024 + h * 128;
      }
      attn_item<2, 128, true>(aQ, ldq, nq, aK, aV, ldk, ldk, nkeys, tlo, thi, qpos0, exp2f(-2.f * (h + 1)) * LOG2E, lam, agate, NZ,
                              aout, 1024, p.g_subln, smem);
    }
  }
  for (int rep = 0; rep < (PROBE_DUP == 8 ? 2 : 1); ++rep)
  while (true) {
    const int it = next_item(counters + 12 + rep * 16, s_item);
    if (it >= 2048 + 32) break;
    const u16 *aQ, *aK, *agate; u16* aout; int nq;
    if (it < 2048) {
      const int tb = it >> 2, h = it & 3; const int b = tb >> 4;
      const long tok0 = (long)tb * 128;
      aQ = Z + tok0 * NZ + 3328 + h * 64; nq = 128;
      aK = (const u16*)(ws + WS_MKV) + (long)b * 256 * 512 + h * 64;
      agate = Z + tok0 * NZ + 3584 + h * 64; aout = MIX + tok0 * 1024 + 768 + h * 64;
    } else {
      const int u = it - 2048; const int b = u >> 2, h = u & 3;
      aQ = ZS + (long)b * 16 * NZ + 3328 + h * 64; nq = 16;
      aK = (const u16*)(ws + WS_MKVS) + (long)b * 256 * 512 + h * 64;
      agate = ZS + (long)b * 16 * NZ + 3584 + h * 64; aout = MIXS + (long)b * 16 * 1024 + 768 + h * 64;
    }
    attn_item<1, 64, false>(aQ, NZ, nq, aK, aK + 256, 512, 512, 256, 4, 4, 0, 0.f, 0.f, agate, NZ, aout, 1024, p.g_subln, smem);
  }
}


DI void grid_barrier(unsigned* ctr, unsigned target) {
  __syncthreads();
  if (threadIdx.x == 0) {
    __builtin_amdgcn_fence(__ATOMIC_RELEASE, "agent");
    asm volatile("s_waitcnt vmcnt(0)" ::: "memory");
    __hip_atomic_fetch_add(ctr, 1u, __ATOMIC_RELAXED, __HIP_MEMORY_SCOPE_AGENT);
    while (__hip_atomic_load(ctr, __ATOMIC_RELAXED, __HIP_MEMORY_SCOPE_AGENT) < target) __builtin_amdgcn_s_sleep(2);
    __builtin_amdgcn_fence(__ATOMIC_ACQUIRE, "agent");
    asm volatile("s_waitcnt vmcnt(0)" ::: "memory");
  }
  __syncthreads();
}

__global__ void __launch_bounds__(512) fwd_megakernel(Params p, int phase_lo, int phase_hi, int coop) {
  extern __shared__ __attribute__((aligned(16))) char smem[];
  cg::grid_group grid = cg::this_grid();
  if (phase_lo <= 0 && phase_hi > 0) phase0(p, smem);
#if PROBE_DUP == 4
  __syncthreads();
  if (phase_lo <= 0 && phase_hi > 0) phase0(p, smem);
#endif
  if (coop) grid.sync();
  if (phase_lo <= 1 && phase_hi > 1) phase1(p, smem);
#if PROBE_DUP == 1
  if (phase_lo <= 1 && phase_hi > 1) phase1(p, smem);
#endif
  unsigned* gctr = (unsigned*)(p.ws + WS_CTL) + 32;
  if (coop) grid_barrier(gctr, gridDim.x);
  if (phase_lo <= 2 && phase_hi > 2) phase2(p, smem, 0);
#if PROBE_DUP == 2
  if (phase_lo <= 2 && phase_hi > 2) phase2(p, smem, 16);
#endif
  if (coop) grid_barrier(gctr, 2u * gridDim.x);
  if (phase_lo <= 3 && phase_hi > 3) phase3(p, smem);
#if PROBE_DUP == 3
  if (phase_lo <= 3 && phase_hi > 3) phase3(p, smem);
#endif
}

extern "C" void kernel_launch(void* const* d_in, const int* in_sizes, int n_in, void* d_out, int out_size,
                              void* d_ws, size_t ws_size, hipStream_t stream) {
  static int grid_blocks = 0;
  if (!grid_blocks) {
    int dev = 0, cus = 0, per_cu = 0;
    (void)hipGetDevice(&dev);
    (void)hipDeviceGetAttribute(&cus, hipDeviceAttributeMultiprocessorCount, dev);
    (void)hipFuncSetAttribute((const void*)fwd_megakernel, hipFuncAttributeMaxDynamicSharedMemorySize, LDS_BYTES);
    (void)hipOccupancyMaxActiveBlocksPerMultiprocessor(&per_cu, fwd_megakernel, 512, LDS_BYTES);
    if (per_cu < 1) per_cu = 1;
    if (per_cu > 1) per_cu = 1;
    grid_blocks = cus * per_cu;
    if (ws_size < WS_END) fprintf(stderr, "workspace too small: %zu < %zu\n", ws_size, (size_t)WS_END);
  }
  Params p{};
  const float** pp = (const float**)&p;
  for (int i = 0; i < 28; ++i) pp[i] = (const float*)d_in[i];
  p.out = (float*)d_out; p.ws = (char*)d_ws;
  int lo = 0, hi = 4, coop = 1;
  void* args[] = {&p, &lo, &hi, &coop};
  hipError_t e = hipLaunchCooperativeKernel((void*)fwd_megakernel, dim3(grid_blocks), dim3(512), args, LDS_BYTES, stream);
  if (e != hipSuccess) fprintf(stderr, "cooperative launch failed: %s (grid %d)\n", hipGetErrorString(e), grid_blocks);
}
```
